# Optimizing an MI355X kernel written in HIP

```python
import math
import jax, jax.numpy as jnp
from jax import lax
import numpy as np

D_MODEL = 1024
BATCH = 8
SEQ = 4096
DEPTH = 2

N_MIXERS = 2
N_A = (DEPTH + 1) // 2
N_B = DEPTH // 2
D_FF = 2816
LRU_WIDTH = D_MODEL
LRU_HEADS = 4
LRU_BLOCK = LRU_WIDTH // LRU_HEADS
CONV_WIDTH = 4
LRU_C = 8.0
HEAD_DIM = 64
N_Q_HEADS = D_MODEL // HEAD_DIM
N_KV_HEADS = 2
Q_PER_KV = N_Q_HEADS // N_KV_HEADS
WINDOW = 128
ATTN_BLOCK = WINDOW
QKV_WIDTH = (N_Q_HEADS + 2 * N_KV_HEADS) * HEAD_DIM
RMS_EPS = 1e-6
NEG_INF = -1e30

kernel_name = "hybrid_rglru_swa_sink_macaron"


def rms_norm(x, g):
    xf = x.astype(jnp.float32)
    y = xf * lax.rsqrt(jnp.mean(xf * xf, axis=-1, keepdims=True) + RMS_EPS)
    return (y * g.astype(jnp.float32)).astype(x.dtype)


def swiglu(x, w_gate, w_up, w_down):
    return (jax.nn.silu(x @ w_gate) * (x @ w_up)) @ w_down


def causal_depthwise_conv(x, w, b):
    s = x.shape[1]
    xp = jnp.pad(x, ((0, 0), (CONV_WIDTH - 1, 0), (0, 0)))
    out = b
    for k in range(CONV_WIDTH):
        out = out + xp[:, k:k + s] * w[k]
    return out


def block_diag_linear(x, w, b):
    bsz, s, _ = x.shape
    xh = x.reshape(bsz, s, LRU_HEADS, LRU_BLOCK)
    y = jnp.einsum('bshi,hij->bshj', xh, w).reshape(bsz, s, LRU_WIDTH)
    return y + b


def _lin_combine(c1, c2):
    a1, b1 = c1
    a2, b2 = c2
    return a1 * a2, a2 * b1 + b2


def rglru_mixer(x, w_in, b_in, conv_w, conv_b, w_a, b_a, w_i, b_i, lam, w_out, b_out):
    proj = x @ w_in + b_in
    y_branch = jax.nn.gelu(proj[..., :LRU_WIDTH])
    xb = causal_depthwise_conv(proj[..., LRU_WIDTH:], conv_w, conv_b)
    r = jax.nn.sigmoid(block_diag_linear(xb, w_a, b_a).astype(jnp.float32))
    i_gate = jax.nn.sigmoid(block_diag_linear(xb, w_i, b_i).astype(jnp.float32))
    log_a = LRU_C * r * jax.nn.log_sigmoid(lam.astype(jnp.float32))
    a = jnp.exp(log_a)
    mult = jnp.sqrt(-jnp.expm1(2.0 * log_a))
    u = mult * (i_gate * xb.astype(jnp.float32))
    _, h = lax.associative_scan(_lin_combine, (a, u), axis=1)
    return (h.astype(x.dtype) * y_branch) @ w_out + b_out


def swa_sink_attention(x, w_qkv, b_qkv, sinks, w_o, b_o):
    bsz, s, _ = x.shape
    nb = s // ATTN_BLOCK
    qkv = x @ w_qkv + b_qkv
    qd = N_Q_HEADS * HEAD_DIM
    kd = N_KV_HEADS * HEAD_DIM
    q = qkv[..., :qd].reshape(bsz, nb, ATTN_BLOCK, N_KV_HEADS, Q_PER_KV, HEAD_DIM)
    k = qkv[..., qd:qd + kd].reshape(bsz, nb, ATTN_BLOCK, N_KV_HEADS, HEAD_DIM)
    v = qkv[..., qd + kd:].reshape(bsz, nb, ATTN_BLOCK, N_KV_HEADS, HEAD_DIM)
    k_prev = jnp.concatenate([jnp.zeros_like(k[:, :1]), k[:, :-1]], axis=1)
    v_prev = jnp.concatenate([jnp.zeros_like(v[:, :1]), v[:, :-1]], axis=1)
    kk = jnp.concatenate([k_prev, k], axis=2)
    vv = jnp.concatenate([v_prev, v], axis=2)
    scale = 1.0 / math.sqrt(HEAD_DIM)
    scores = jnp.einsum('bnqkgd,bnskd->bnkgqs', q, kk).astype(jnp.float32) * scale
    qi = jnp.arange(ATTN_BLOCK)[:, None]
    kj = jnp.arange(2 * ATTN_BLOCK)[None, :]
    diff = qi + ATTN_BLOCK - kj
    band = (diff >= 0) & (diff < WINDOW)
    blk_idx = jnp.arange(nb)[:, None, None]
    valid = band[None] & ((blk_idx > 0) | (kj[None] >= ATTN_BLOCK))
    scores = jnp.where(valid[None, :, None, None], scores, NEG_INF)
    sink = jnp.broadcast_to(
        sinks.astype(jnp.float32).reshape(1, 1, N_KV_HEADS, Q_PER_KV, 1, 1),
        scores.shape[:-1] + (1,))
    probs = jax.nn.softmax(jnp.concatenate([scores, sink], axis=-1), axis=-1)[..., :-1]
    out = jnp.einsum('bnkgqs,bnskd->bnqkgd', probs.astype(x.dtype), vv)
    return out.reshape(bsz, s, qd) @ w_o + b_o


def setup_inputs(seed: int = 0) -> dict:
    key = jax.random.key(seed)
    ks = iter(jax.random.split(key, 40))
    f32 = jnp.float32

    def nrm(shape, fan_in):
        return jax.random.normal(next(ks), shape, f32) * (fan_in ** -0.5)

    def gain(shape):
        return 1.0 + 0.05 * jax.random.normal(next(ks), shape, f32)

    def bias(shape):
        return 0.01 * jax.random.normal(next(ks), shape, f32)

    x = jax.random.normal(next(ks), (BATCH, SEQ, D_MODEL), f32)
    norm_ffn = gain((DEPTH, 2, 2, D_MODEL))
    norm_mix = gain((DEPTH, 2, D_MODEL))
    ffn_w_gate = nrm((DEPTH, 2, D_MODEL, D_FF), D_MODEL)
    ffn_w_up = nrm((DEPTH, 2, D_MODEL, D_FF), D_MODEL)
    ffn_w_down = nrm((DEPTH, 2, D_FF, D_MODEL), D_FF)
    lru_w_in = nrm((N_A, D_MODEL, 2 * LRU_WIDTH), D_MODEL)
    lru_b_in = bias((N_A, 2 * LRU_WIDTH))
    lru_conv_w = nrm((N_A, CONV_WIDTH, LRU_WIDTH), CONV_WIDTH)
    lru_conv_b = bias((N_A, LRU_WIDTH))
    lru_w_a = nrm((N_A, LRU_HEADS, LRU_BLOCK, LRU_BLOCK), LRU_BLOCK)
    lru_b_a = bias((N_A, LRU_WIDTH))
    lru_w_i = nrm((N_A, LRU_HEADS, LRU_BLOCK, LRU_BLOCK), LRU_BLOCK)
    lru_b_i = bias((N_A, LRU_WIDTH))
    a0 = jax.random.uniform(next(ks), (N_A, LRU_WIDTH), f32, 0.81, 0.998)
    base = a0 ** (1.0 / LRU_C)
    lru_lambda = jnp.log(base) - jnp.log1p(-base)
    lru_w_out = nrm((N_A, LRU_WIDTH, D_MODEL), LRU_WIDTH)
    lru_b_out = bias((N_A, D_MODEL))
    attn_w_qkv = nrm((N_B, D_MODEL, QKV_WIDTH), D_MODEL)
    attn_b_qkv = bias((N_B, QKV_WIDTH))
    attn_sinks = jax.random.normal(next(ks), (N_B, N_Q_HEADS), f32)
    attn_w_o = nrm((N_B, N_Q_HEADS * HEAD_DIM, D_MODEL), N_Q_HEADS * HEAD_DIM)
    attn_b_o = bias((N_B, D_MODEL))
    return {"x": x, "norm_ffn": norm_ffn, "norm_mix": norm_mix,
            "ffn_w_gate": ffn_w_gate, "ffn_w_up": ffn_w_up, "ffn_w_down": ffn_w_down,
            "lru_w_in": lru_w_in, "lru_b_in": lru_b_in, "lru_conv_w": lru_conv_w,
            "lru_conv_b": lru_conv_b, "lru_w_a": lru_w_a, "lru_b_a": lru_b_a,
            "lru_w_i": lru_w_i, "lru_b_i": lru_b_i, "lru_lambda": lru_lambda,
            "lru_w_out": lru_w_out, "lru_b_out": lru_b_out,
            "attn_w_qkv": attn_w_qkv, "attn_b_qkv": attn_b_qkv, "attn_sinks": attn_sinks,
            "attn_w_o": attn_w_o, "attn_b_o": attn_b_o}


def reference(x, norm_ffn, norm_mix, ffn_w_gate, ffn_w_up, ffn_w_down,
              lru_w_in, lru_b_in, lru_conv_w, lru_conv_b, lru_w_a, lru_b_a,
              lru_w_i, lru_b_i, lru_lambda, lru_w_out, lru_b_out,
              attn_w_qkv, attn_b_qkv, attn_sinks, attn_w_o, attn_b_o):
    h = x
    for layer in range(DEPTH):
        f = swiglu(rms_norm(h, norm_ffn[layer, 0, 0]),
                   ffn_w_gate[layer, 0], ffn_w_up[layer, 0], ffn_w_down[layer, 0])
        h = h + 0.5 * rms_norm(f, norm_ffn[layer, 0, 1])
        hn = rms_norm(h, norm_mix[layer, 0])
        j = layer // N_MIXERS
        if layer % N_MIXERS == 0:
            m = rglru_mixer(hn, lru_w_in[j], lru_b_in[j], lru_conv_w[j], lru_conv_b[j],
                            lru_w_a[j], lru_b_a[j], lru_w_i[j], lru_b_i[j],
                            lru_lambda[j], lru_w_out[j], lru_b_out[j])
        else:
            m = swa_sink_attention(hn, attn_w_qkv[j], attn_b_qkv[j], attn_sinks[j],
                                   attn_w_o[j], attn_b_o[j])
        h = h + rms_norm(m, norm_mix[layer, 1])
        f = swiglu(rms_norm(h, norm_ffn[layer, 1, 0]),
                   ffn_w_gate[layer, 1], ffn_w_up[layer, 1], ffn_w_down[layer, 1])
        h = h + 0.5 * rms_norm(f, norm_ffn[layer, 1, 1])
    return h
```

```cpp
#include <hip/hip_runtime.h>
#include <hip/hip_cooperative_groups.h>
#include <cstdio>
namespace cg = cooperative_groups;

#ifndef N_LAUNCH_PER_PHASE
#define N_LAUNCH_PER_PHASE 0
#endif

#define LAS __attribute__((address_space(3)))
typedef unsigned short bf16_t;
typedef short bf16x8 __attribute__((ext_vector_type(8)));
typedef float f32x4 __attribute__((ext_vector_type(4)));
typedef unsigned u32x4 __attribute__((ext_vector_type(4)));
typedef unsigned u32x2 __attribute__((ext_vector_type(2)));

constexpr int T_ = 32768, D_ = 1024, F_ = 2816, S_ = 4096;
constexpr int NPHASE = 24;
constexpr int LDS_GEMM = 131072;
constexpr int LDS_BYTES = LDS_GEMM + 16;

constexpr size_t OFF_LSL   = 16384;
constexpr size_t OFF_RSQ   = 32768;
constexpr size_t OFF_WT1   = 32768 + 131072;
constexpr size_t SZ_WT1    = (size_t)5632 * 1024 * 2;
constexpr size_t OFF_WT2   = OFF_WT1 + 4 * SZ_WT1;
constexpr size_t SZ_WT2    = (size_t)1024 * 2816 * 2;
constexpr size_t OFF_WIN   = OFF_WT2 + 4 * SZ_WT2;
constexpr size_t OFF_WGATE = OFF_WIN + (size_t)2048 * 1024 * 2;
constexpr size_t OFF_WOUT  = OFF_WGATE + (size_t)2048 * 256 * 2;
constexpr size_t OFF_WQKV  = OFF_WOUT + (size_t)1024 * 1024 * 2;
constexpr size_t OFF_WO    = OFF_WQKV + (size_t)1280 * 1024 * 2;
constexpr size_t OFF_ABUF  = OFF_WO + (size_t)1024 * 1024 * 2;
constexpr size_t SZ_TD2    = (size_t)T_ * D_ * 2;
constexpr size_t OFF_FBUF  = OFF_ABUF + SZ_TD2;
constexpr size_t OFF_HBUF  = OFF_FBUF + SZ_TD2;
constexpr size_t OFF_EBUF  = OFF_HBUF + (size_t)T_ * F_ * 2;
constexpr size_t WS_END    = OFF_EBUF + (size_t)T_ * D_ * 4;

struct Args {
    const float* in[22];
    float* out;
    unsigned char* ws;
    int ph_lo, ph_hi;
};

typedef const __attribute__((address_space(4))) Args KArgs;

__device__ __forceinline__ int opaque_bid() { int b = (int)blockIdx.x; asm volatile("" : "+s"(b)); return b; }
__device__ __forceinline__ int opaque_nblk() { int b = (int)gridDim.x; asm volatile("" : "+s"(b)); return b; }
__device__ __forceinline__ int opaque_tid() { int t = (int)threadIdx.x; asm volatile("" : "+v"(t)); return t; }
__device__ __forceinline__ unsigned pk2(float lo, float hi) { unsigned r; asm("v_cvt_pk_bf16_f32 %0, %1, %2" : "=v"(r) : "v"(lo), "v"(hi)); return r; }
__device__ __forceinline__ float bflo(unsigned w) { return __uint_as_float(w << 16); }
__device__ __forceinline__ float bfhi(unsigned w) { return __uint_as_float(w & 0xffff0000u); }
__device__ __forceinline__ f32x4 unpack4(u32x2 w) { return (f32x4){bflo(w.x), bfhi(w.x), bflo(w.y), bfhi(w.y)}; }
__device__ __forceinline__ u32x2 pack4(f32x4 v) { return (u32x2){pk2(v[0], v[1]), pk2(v[2], v[3])}; }
__device__ __forceinline__ float wave_sum(float v) {
#pragma unroll
    for (int o = 32; o > 0; o >>= 1) v += __shfl_xor(v, o);
    return v;
}
__device__ __forceinline__ float sigmoidf_(float x) { return __builtin_amdgcn_rcpf(1.0f + __expf(-x)); }
__device__ __forceinline__ float gelu_tanh(float v) {
    const float z = 0.7978845608028654f * (v + 0.044715f * v * v * v);
    const float t = 1.0f - 2.0f * __builtin_amdgcn_rcpf(__expf(2.0f * z) + 1.0f);
    return 0.5f * v * (1.0f + t);
}

namespace pg8 {
constexpr int BM = 256, BK = 64, HALF = 128, HTB = HALF * BK * 2, NXCD = 8, WGM = 8;
__device__ __forceinline__ int lds_byte(int r, int c) { const int st = (r >> 4) * 2 + (c >> 5), rr = r & 15, cc = c & 31, ob = rr * 64 + cc * 2; return st * 1024 + (ob ^ (((ob >> 9) & 1) << 5)); }
__device__ __forceinline__ void stage_rc(int b, int& R, int& C) { const int st = b / 1024, sb = b % 1024, swz = sb ^ (((sb >> 9) & 1) << 5); R = (st >> 1) * 16 + swz / 64; C = (st & 1) * 32 + (swz % 64) / 2; }

struct Unit { int pm, pn; };
struct Gemm { const bf16_t* A; const bf16_t* Bt; int M, N, K, lda, headK; };

struct StaticOrder {
    int nM, nN, nwg, G, c;
    __device__ void init(int M, int N, int G_, int c_) { nM = M / BM; nN = N / BM; nwg = nM * nN; G = G_; c = c_; }
    __device__ bool next(int i, Unit& u) const {
        const long L = (long)i * G + c; if (L >= nwg) return false;
        int wgid = (int)L; { const int q = nwg / NXCD, r = nwg % NXCD, xcd = wgid % NXCD, off = wgid / NXCD; wgid = (xcd < r ? xcd * (q + 1) : r * (q + 1) + (xcd - r) * q) + off; }
        const int nig = WGM * nN, gid = wgid / nig, fm = gid * WGM, gsz = (nM - fm) < WGM ? (nM - fm) : WGM;
        u.pm = fm + ((wgid % nig) % gsz); u.pn = (wgid % nig) / gsz; return true;
    }
};

template <class Epi>
__device__ __forceinline__ void gemm_phase(LAS unsigned char* lds, const Gemm g, const StaticOrder& S, const Epi& E) {
    const int tid = opaque_tid(), wid = __builtin_amdgcn_readfirstlane(tid >> 6), lane = tid & 63, wr = wid >> 2, wc = wid & 3, fr = lane & 15, fq = lane >> 4;
    int K = g.K; asm volatile("" : "+s"(K));
    const int nt = K / BK;
    unsigned voffA[2], voffB[2];
#pragma unroll
    for (int i = 0; i < 2; ++i) { int R, C; stage_rc(tid * 16 + i * 8192, R, C);
        voffA[i] = (unsigned)(R * g.lda + C) * 2u; voffB[i] = (unsigned)(R * K + C) * 2u; }
    const size_t kstep = (size_t)(BK * 2);
    const size_t hstepA = (size_t)HALF * g.lda * 2, hstepB = (size_t)HALF * K * 2;
    const size_t tstepA = 2 * hstepA, tstepB = 2 * hstepB;
    const unsigned ldsw = (unsigned)wid * 1024u;
    const int aoff = lds_byte(wr * 64 + fr, fq * 8), boff = lds_byte(wc * 32 + fr, fq * 8);
#define PG8_SA(b, h) (((b) * 2 + (h)) * HTB)
#define PG8_SB(b, h) ((4 + (b) * 2 + (h)) * HTB)
#define PG8_STAGE(bufoff, gbase, voff) do { _Pragma("unroll") for (int _i = 0; _i < 2; ++_i) \
        __builtin_amdgcn_global_load_lds((const unsigned*)((const char*)(gbase) + (voff)[_i]), (LAS unsigned*)(lds + (bufoff) + ldsw + _i * 8192), 16, 0, 0); } while (0)
#define PG8_LDA(dst, b, h) do { _Pragma("unroll") for (int m = 0; m < 4; ++m) _Pragma("unroll") for (int k = 0; k < 2; ++k) dst[m][k] = *(const LAS bf16x8*)(lds + PG8_SA(b, h) + aoff + m * 2048 + k * 1024); } while (0)
#define PG8_LDB(dst, b, h) do { _Pragma("unroll") for (int n = 0; n < 2; ++n) _Pragma("unroll") for (int k = 0; k < 2; ++k) dst[n][k] = *(const LAS bf16x8*)(lds + PG8_SB(b, h) + boff + n * 2048 + k * 1024); } while (0)
#define PG8_MMA(ai, bj, At, Bt) do { __builtin_amdgcn_s_setprio(1); _Pragma("unroll") for (int m = 0; m < 4; ++m) _Pragma("unroll") for (int n = 0; n < 2; ++n) _Pragma("unroll") for (int k = 0; k < 2; ++k) \
        acc[ai][bj][m][n] = __builtin_amdgcn_mfma_f32_16x16x32_bf16(Bt[n][k], At[m][k], acc[ai][bj][m][n], 0, 0, 0); __builtin_amdgcn_s_setprio(0); } while (0)
#define PG8_WAIT_V(n) asm volatile("s_waitcnt vmcnt(" #n ")" ::: "memory")
#define PG8_WAIT_L(n) asm volatile("s_waitcnt lgkmcnt(" #n ")" ::: "memory")
#define PG8_BAR __builtin_amdgcn_s_barrier()
#define PG8_SCHED __builtin_amdgcn_sched_barrier(0)
    Unit cur, nxt; int ui = 0;
    if (!S.next(0, cur)) return;
    f32x4 acc[2][2][4][2];
#pragma unroll
    for (int a = 0; a < 2; ++a)
#pragma unroll
        for (int b = 0; b < 2; ++b)
#pragma unroll
            for (int m = 0; m < 4; ++m)
#pragma unroll
                for (int n = 0; n < 2; ++n) acc[a][b][m][n] = (f32x4){0.f, 0.f, 0.f, 0.f};
    bf16x8 At[4][2], B0[2][2], B1[2][2];
    const char* cA = (const char*)g.A + (size_t)cur.pm * tstepA + (size_t)((cur.pn >> 1) * g.headK) * 2; const char* cB = (const char*)g.Bt + (size_t)cur.pn * tstepB;
    PG8_STAGE(PG8_SB(0, 0), cB, voffB); PG8_STAGE(PG8_SA(0, 0), cA, voffA); PG8_STAGE(PG8_SB(0, 1), cB + hstepB, voffB); PG8_STAGE(PG8_SA(0, 1), cA + hstepA, voffA);
    if (wr == 1) PG8_BAR;
    PG8_WAIT_V(4); PG8_BAR;
    PG8_STAGE(PG8_SB(1, 0), cB + kstep, voffB); PG8_STAGE(PG8_SA(1, 0), cA + kstep, voffA); PG8_STAGE(PG8_SB(1, 1), cB + hstepB + kstep, voffB);
    PG8_WAIT_V(6); PG8_BAR;
    for (;;) {
        const bool has_next = S.next(ui + 1, nxt);
        const char* nA = has_next ? (const char*)g.A + (size_t)nxt.pm * tstepA + (size_t)((nxt.pn >> 1) * g.headK) * 2 : cA; const char* nB = has_next ? (const char*)g.Bt + (size_t)nxt.pn * tstepB : cB;
        for (int t = 0; t < nt; t += 2) {
            const bool last = (t == nt - 2);
            const char* a1 = cA + (size_t)(t + 1) * kstep;
            const char* a2 = last ? nA : cA + (size_t)(t + 2) * kstep; const char* b2 = last ? nB : cB + (size_t)(t + 2) * kstep;
            const char* a3 = a2 + kstep; const char* b3 = b2 + kstep;
            PG8_LDB(B0, 0, 0); PG8_SCHED; PG8_LDA(At, 0, 0); PG8_STAGE(PG8_SA(1, 1), a1 + hstepA, voffA);
            PG8_WAIT_L(8); PG8_BAR; PG8_WAIT_L(0); PG8_MMA(0, 0, At, B0); PG8_BAR; PG8_SCHED;
            PG8_LDB(B1, 0, 1); PG8_STAGE(PG8_SB(0, 0), b2, voffB);
            PG8_BAR; PG8_WAIT_L(0); PG8_MMA(0, 1, At, B1); PG8_BAR;
            PG8_LDA(At, 0, 1); PG8_STAGE(PG8_SA(0, 0), a2, voffA);
            PG8_BAR; PG8_WAIT_L(0); PG8_MMA(1, 0, At, B0); PG8_BAR; PG8_SCHED;
            PG8_STAGE(PG8_SB(0, 1), b2 + hstepB, voffB);
            PG8_WAIT_V(6); PG8_BAR; PG8_MMA(1, 1, At, B1); PG8_BAR;
            PG8_LDB(B0, 1, 0); PG8_SCHED; PG8_LDA(At, 1, 0); PG8_STAGE(PG8_SA(0, 1), a2 + hstepA, voffA);
            PG8_WAIT_L(8); PG8_BAR; PG8_WAIT_L(0); PG8_MMA(0, 0, At, B0); PG8_BAR; PG8_SCHED;
            PG8_LDB(B1, 1, 1); PG8_STAGE(PG8_SB(1, 0), b3, voffB);
            PG8_BAR; PG8_WAIT_L(0); PG8_MMA(0, 1, At, B1); PG8_BAR;
            PG8_LDA(At, 1, 1); PG8_STAGE(PG8_SA(1, 0), a3, voffA);
            PG8_BAR; PG8_WAIT_L(0); PG8_MMA(1, 0, At, B0); PG8_BAR; PG8_SCHED;
            PG8_STAGE(PG8_SB(1, 1), b3 + hstepB, voffB);
            PG8_WAIT_V(6); PG8_BAR; PG8_MMA(1, 1, At, B1); PG8_BAR;
        }
        E(acc, cur, wr, wc, fr, fq);
        if (!has_next) break;
#pragma unroll
        for (int a = 0; a < 2; ++a)
#pragma unroll
            for (int b = 0; b < 2; ++b)
#pragma unroll
                for (int m = 0; m < 4; ++m)
#pragma unroll
                    for (int n = 0; n < 2; ++n) acc[a][b][m][n] = (f32x4){0.f, 0.f, 0.f, 0.f};
        cur = nxt; cA = nA; cB = nB; ++ui;
    }
    PG8_WAIT_V(0);
    if (wr == 0) PG8_BAR;
    PG8_BAR;
#undef PG8_SA
#undef PG8_SB
#undef PG8_STAGE
#undef PG8_LDA
#undef PG8_LDB
#undef PG8_MMA
#undef PG8_WAIT_V
#undef PG8_WAIT_L
#undef PG8_BAR
#undef PG8_SCHED
}

struct EpiStore {
    bf16_t* O; int ldc; const float* bias;
    __device__ __forceinline__ void operator()(const f32x4 (&acc)[2][2][4][2], const Unit& u, int wr, int wc, int fr, int fq) const {
        const int row0 = u.pm * BM + wr * 64 + fr, col0 = u.pn * BM + wc * 32 + 4 * fq;
        f32x4 bv[2][2];
#pragma unroll
        for (int bj = 0; bj < 2; ++bj)
#pragma unroll
            for (int n = 0; n < 2; ++n) bv[bj][n] = bias ? *(const f32x4*)(bias + col0 + bj * HALF + n * 16) : (f32x4){0.f, 0.f, 0.f, 0.f};
#pragma unroll
        for (int ai = 0; ai < 2; ++ai)
#pragma unroll
            for (int m = 0; m < 4; ++m) { bf16_t* rowp = O + (size_t)(row0 + ai * HALF + m * 16) * ldc + col0;
#pragma unroll
                for (int bj = 0; bj < 2; ++bj)
#pragma unroll
                    for (int n = 0; n < 2; ++n) *(u32x2*)(rowp + bj * HALF + n * 16) = pack4(acc[ai][bj][m][n] + bv[bj][n]); }
    }
};
struct EpiG1 {
    bf16_t* H;
    __device__ __forceinline__ void operator()(const f32x4 (&acc)[2][2][4][2], const Unit& u, int wr, int wc, int fr, int fq) const {
        const int row0 = u.pm * BM + wr * 64 + fr, hc0 = u.pn * 128 + wc * 16 + 4 * fq;
#pragma unroll
        for (int ai = 0; ai < 2; ++ai)
#pragma unroll
            for (int m = 0; m < 4; ++m) { bf16_t* rowp = H + (size_t)(row0 + ai * HALF + m * 16) * F_ + hc0;
#pragma unroll
                for (int bj = 0; bj < 2; ++bj) { const f32x4 gt = acc[ai][bj][m][0], up = acc[ai][bj][m][1]; f32x4 v;
#pragma unroll
                    for (int j = 0; j < 4; ++j) v[j] = gt[j] * sigmoidf_(gt[j]) * up[j];
                    *(u32x2*)(rowp + bj * 64) = pack4(v); } }
    }
};
struct EpiGP {
    bf16_t* Y; bf16_t* X; const float* bias;
    __device__ __forceinline__ void operator()(const f32x4 (&acc)[2][2][4][2], const Unit& u, int wr, int wc, int fr, int fq) const {
        const bool isy = u.pn < 4;
        const int row0 = u.pm * BM + wr * 64 + fr, col0 = (u.pn & 3) * BM + wc * 32 + 4 * fq, bcol0 = u.pn * BM + wc * 32 + 4 * fq;
        bf16_t* dst = isy ? Y : X;
        f32x4 bv[2][2];
#pragma unroll
        for (int bj = 0; bj < 2; ++bj)
#pragma unroll
            for (int n = 0; n < 2; ++n) bv[bj][n] = *(const f32x4*)(bias + bcol0 + bj * HALF + n * 16);
#pragma unroll
        for (int ai = 0; ai < 2; ++ai)
#pragma unroll
            for (int m = 0; m < 4; ++m) { bf16_t* rowp = dst + (size_t)(row0 + ai * HALF + m * 16) * D_ + col0;
#pragma unroll
                for (int bj = 0; bj < 2; ++bj)
#pragma unroll
                    for (int n = 0; n < 2; ++n) { f32x4 v = acc[ai][bj][m][n] + bv[bj][n];
                        if (isy) {
#pragma unroll
                            for (int j = 0; j < 4; ++j) v[j] = gelu_tanh(v[j]); }
                        *(u32x2*)(rowp + bj * HALF + n * 16) = pack4(v); }
                __builtin_amdgcn_sched_barrier(0); }
    }
};
struct EpiGG {
    const bf16_t* XB; const float* ba; const float* bi; const float* lsl; float* Aout; bf16_t* Uout;
    __device__ __forceinline__ void operator()(const f32x4 (&acc)[2][2][4][2], const Unit& u, int wr, int wc, int fr, int fq) const {
        const unsigned ch0 = (unsigned)(u.pn * 128 + wc * 16 + 4 * fq);
        const unsigned o0 = (unsigned)(u.pm * BM + wr * 64 + fr) * (unsigned)D_ + ch0;
#pragma unroll
        for (int bj = 0; bj < 2; ++bj) { const unsigned ch = ch0 + bj * 64;
            const f32x4 bav = *(const f32x4*)(ba + ch), biv = *(const f32x4*)(bi + ch), ls = *(const f32x4*)(lsl + ch);
#pragma unroll
            for (int ai = 0; ai < 2; ++ai)
#pragma unroll
                for (int m = 0; m < 4; ++m) { const unsigned o = o0 + (unsigned)((ai * HALF + m * 16) * D_ + bj * 64);
                    const f32x4 xb = unpack4(*(const u32x2*)(XB + o));
                    const f32x4 pr = acc[ai][bj][m][0] + bav, pi = acc[ai][bj][m][1] + biv; f32x4 av, uv;
#pragma unroll
                    for (int j = 0; j < 4; ++j) { const float rg = sigmoidf_(pr[j]), ig = sigmoidf_(pi[j]); const float la = rg * ls[j];
                        const float a_ = __expf(la); av[j] = a_; uv[j] = __builtin_amdgcn_sqrtf(fmaxf(1.0f - a_ * a_, 0.f)) * ig * xb[j]; }
                    *(f32x4*)(Aout + o) = av; *(u32x2*)(Uout + o) = pack4(uv);
                    __builtin_amdgcn_sched_barrier(0); } }
    }
};
}

__device__ void phase_wconv(const KArgs& a, LAS unsigned char* lds) {
    LAS float* tl = (LAS float*)lds;
    const int tid = opaque_tid();
    unsigned char* ws = a.ws;
    const int bid = opaque_bid(), nblk = opaque_nblk();
    if (bid == nblk - 1) {
        float* lsl = (float*)(ws + OFF_LSL);
        for (int ch = tid; ch < 1024; ch += 512) { const float lam = a.in[14][ch]; lsl[ch] = -8.0f * log1pf(expf(-lam)); }
    }
    for (int tile = bid; tile < 2480; tile += nblk) {
        int t = tile, mode, K, ld; const float* s0; const float* s1 = nullptr; const float* gk = nullptr; bf16_t* dst;
        if (t < 1408)      { const int f = t / 352; t -= f * 352; mode = 1; K = 1024; ld = 2816; s0 = a.in[3] + (size_t)f * 1024 * 2816; s1 = a.in[4] + (size_t)f * 1024 * 2816; gk = a.in[1] + f * 2048; dst = (bf16_t*)(ws + OFF_WT1 + f * SZ_WT1); }
        else if (t < 2112) { t -= 1408; const int f = t / 176; t -= f * 176; mode = 0; K = 2816; ld = 1024; s0 = a.in[5] + (size_t)f * 2816 * 1024; dst = (bf16_t*)(ws + OFF_WT2 + f * SZ_WT2); }
        else if (t < 2240) { t -= 2112; mode = 0; K = 1024; ld = 2048; s0 = a.in[6]; gk = a.in[2]; dst = (bf16_t*)(ws + OFF_WIN); }
        else if (t < 2272) { t -= 2240; mode = 2; K = 256; ld = 256; s0 = a.in[10]; s1 = a.in[12]; dst = (bf16_t*)(ws + OFF_WGATE); }
        else if (t < 2336) { t -= 2272; mode = 0; K = 1024; ld = 1024; s0 = a.in[15]; dst = (bf16_t*)(ws + OFF_WOUT); }
        else if (t < 2416) { t -= 2336; mode = 0; K = 1024; ld = 1280; s0 = a.in[17]; gk = a.in[2] + 2048; dst = (bf16_t*)(ws + OFF_WQKV); }
        else               { t -= 2416; mode = 0; K = 1024; ld = 1024; s0 = a.in[20]; dst = (bf16_t*)(ws + OFF_WO); }
        const int nk = K >> 8, ct = t / nk, kt = t - ct * nk, c0 = ct * 64, k0 = kt * 256;
        const int cl = tid & 63, c = c0 + cl;
        const float* cp;
        if (mode == 0) cp = s0 + c;
        else { const int chn = (c >> 5) * 16 + (c & 15), n = (c >> 4) & 1;
            if (mode == 1) cp = (n ? s1 : s0) + chn;
            else cp = (n ? s1 : s0) + (chn >> 8) * 65536 + (chn & 255); }
        const int kl0 = tid >> 6;
        __syncthreads();
#pragma unroll
        for (int q = 0; q < 4; ++q)
#pragma unroll
            for (int i = 0; i < 8; ++i) { const int kl = kl0 + 8 * i, k = k0 + 64 * q + kl; float v = cp[(size_t)k * ld]; if (gk) v *= gk[k]; tl[q * 4160 + cl * 65 + kl] = v; }
        __syncthreads();
        const int cw = tid >> 3, kc = tid & 7;
#pragma unroll
        for (int q = 0; q < 4; ++q) { const LAS float* tp = tl + q * 4160 + cw * 65 + 8 * kc;
            *(u32x4*)(dst + (size_t)(c0 + cw) * K + k0 + 64 * q + 8 * kc) = (u32x4){pk2(tp[0], tp[1]), pk2(tp[2], tp[3]), pk2(tp[4], tp[5]), pk2(tp[6], tp[7])}; }
    }
    __syncthreads();
}

__device__ void phase_row(const bf16_t* f, const float* gpost, float scale, const float* x, bf16_t* hb, float* rinv, float* out, int mode) {
    const int tid = opaque_tid(), lane = tid & 63, wid = tid >> 6;
    const int gw = opaque_bid() * 8 + wid, nw = opaque_nblk() * 8;
    f32x4 gp[4];
    if (mode != 0) {
#pragma unroll
        for (int i = 0; i < 4; ++i) gp[i] = *(const f32x4*)(gpost + 8 * lane + 512 * (i >> 1) + 4 * (i & 1));
    }
    for (int row0 = gw * 4; row0 < T_; row0 += nw * 4) {
        f32x4 h[4][4]; u32x4 fw[4][2]; float ri[4];
        if (mode == 0) {
#pragma unroll
            for (int r = 0; r < 4; ++r)
#pragma unroll
                for (int i = 0; i < 4; ++i) h[r][i] = *(const f32x4*)(x + (size_t)(row0 + r) * D_ + 8 * lane + 512 * (i >> 1) + 4 * (i & 1));
        } else {
            u32x4 hw[4][2];
#pragma unroll
            for (int r = 0; r < 4; ++r) { ri[r] = rinv[row0 + r];
#pragma unroll
                for (int c = 0; c < 2; ++c) { hw[r][c] = *(const u32x4*)(hb + (size_t)(row0 + r) * D_ + 8 * lane + 512 * c); fw[r][c] = *(const u32x4*)(f + (size_t)(row0 + r) * D_ + 8 * lane + 512 * c); } }
#pragma unroll
            for (int r = 0; r < 4; ++r) {
                float ss = 0.f; f32x4 fv[4];
#pragma unroll
                for (int c = 0; c < 2; ++c) { fv[2 * c] = unpack4((u32x2){fw[r][c].x, fw[r][c].y}); fv[2 * c + 1] = unpack4((u32x2){fw[r][c].z, fw[r][c].w});
                    h[r][2 * c] = unpack4((u32x2){hw[r][c].x, hw[r][c].y}) * ri[r]; h[r][2 * c + 1] = unpack4((u32x2){hw[r][c].z, hw[r][c].w}) * ri[r]; }
#pragma unroll
                for (int i = 0; i < 4; ++i) ss += fv[i][0] * fv[i][0] + fv[i][1] * fv[i][1] + fv[i][2] * fv[i][2] + fv[i][3] * fv[i][3];
                ss = wave_sum(ss);
                const float rs = rsqrtf(ss * (1.0f / 1024.0f) + 1e-6f) * scale;
#pragma unroll
                for (int i = 0; i < 4; ++i) h[r][i] += fv[i] * rs * gp[i];
            }
        }
        if (mode == 2) {
#pragma unroll
            for (int r = 0; r < 4; ++r)
#pragma unroll
                for (int i = 0; i < 4; ++i) *(f32x4*)(out + (size_t)(row0 + r) * D_ + 8 * lane + 512 * (i >> 1) + 4 * (i & 1)) = h[r][i];
        } else {
#pragma unroll
            for (int r = 0; r < 4; ++r) {
                float ss = 0.f;
#pragma unroll
                for (int i = 0; i < 4; ++i) ss += h[r][i][0] * h[r][i][0] + h[r][i][1] * h[r][i][1] + h[r][i][2] * h[r][i][2] + h[r][i][3] * h[r][i][3];
                ss = wave_sum(ss);
                const float ms = ss * (1.0f / 1024.0f) + 1e-6f, rs = rsqrtf(ms);
#pragma unroll
                for (int c = 0; c < 2; ++c) { const u32x2 lo = pack4(h[r][2 * c] * rs), hi = pack4(h[r][2 * c + 1] * rs);
                    *(u32x4*)(hb + (size_t)(row0 + r) * D_ + 8 * lane + 512 * c) = (u32x4){lo.x, lo.y, hi.x, hi.y}; }
                if (lane == 0) rinv[row0 + r] = ms * rs;
            }
        }
    }
}

__device__ void phase_conv(const bf16_t* xpre, const float* cw, const float* cb, bf16_t* xb) {
    const int gt = opaque_bid() * 512 + opaque_tid(), nt = opaque_nblk() * 512;
    for (int idx = gt; idx < T_ * 128; idx += nt) {
        const int t = idx >> 7, ch = (idx & 127) * 8, s = t & (S_ - 1);
        f32x4 a0 = *(const f32x4*)(cb + ch), a1 = *(const f32x4*)(cb + ch + 4);
#pragma unroll
        for (int k = 0; k < 4; ++k) { const int ds = 3 - k;
            if (s >= ds) { const u32x4 w = *(const u32x4*)(xpre + (size_t)(t - ds) * D_ + ch);
                const f32x4 w0 = *(const f32x4*)(cw + k * D_ + ch), w1 = *(const f32x4*)(cw + k * D_ + ch + 4);
                a0 += w0 * (f32x4){bflo(w.x), bfhi(w.x), bflo(w.y), bfhi(w.y)}; a1 += w1 * (f32x4){bflo(w.z), bfhi(w.z), bflo(w.w), bfhi(w.w)}; } }
        *(u32x4*)(xb + (size_t)t * D_ + ch) = (u32x4){pk2(a0[0], a0[1]), pk2(a0[2], a0[3]), pk2(a1[0], a1[1]), pk2(a1[2], a1[3])};
    }
}

__device__ void phase_scan1(const float* A, const bf16_t* U, float* P, float* H) {
    const int gt = opaque_bid() * 512 + opaque_tid(), nt = opaque_nblk() * 512;
    for (int it = gt; it < 131072; it += nt) {
        const int c4 = it & 255, bc = it >> 8;
        const size_t base = (size_t)bc * 64 * D_ + c4 * 4;
        f32x4 h = {0.f, 0.f, 0.f, 0.f}, p = {1.f, 1.f, 1.f, 1.f};
#pragma unroll 8
        for (int s = 0; s < 64; ++s) { const f32x4 av = *(const f32x4*)(A + base + (size_t)s * D_); const f32x4 uv = unpack4(*(const u32x2*)(U + base + (size_t)s * D_)); h = av * h + uv; p *= av; }
        *(f32x4*)(P + (size_t)bc * D_ + c4 * 4) = p; *(f32x4*)(H + (size_t)bc * D_ + c4 * 4) = h;
    }
}
__device__ void phase_scan2(const float* A, const bf16_t* U, const float* P, const float* H, bf16_t* Y) {
    const int gt = opaque_bid() * 512 + opaque_tid(), nt = opaque_nblk() * 512;
    for (int it = gt; it < 131072; it += nt) {
        const int c4 = it & 255, bc = it >> 8, c = bc & 63, b0 = bc - c;
        f32x4 h = {0.f, 0.f, 0.f, 0.f};
#pragma unroll 4
        for (int cc = 0; cc < c; ++cc) { const size_t o = (size_t)(b0 + cc) * D_ + c4 * 4; const f32x4 pp = *(const f32x4*)(P + o), hh = *(const f32x4*)(H + o); h = pp * h + hh; }
        const size_t base = (size_t)bc * 64 * D_ + c4 * 4;
#pragma unroll 8
        for (int s = 0; s < 64; ++s) { const size_t o = base + (size_t)s * D_;
            const f32x4 av = *(const f32x4*)(A + o); const f32x4 uv = unpack4(*(const u32x2*)(U + o)); const f32x4 yv = unpack4(*(const u32x2*)(Y + o));
            h = av * h + uv; *(u32x2*)(Y + o) = pack4(h * yv); }
    }
}

__device__ void phase_attn(LAS unsigned char* lds, const bf16_t* qkv, const float* sinks, bf16_t* out) {
    const int tid = opaque_tid(), lane = tid & 63, wid = __builtin_amdgcn_readfirstlane(tid >> 6), fr = lane & 15, g = lane >> 4;
    LAS unsigned char* Ks = lds;
    LAS unsigned char* Vt = lds + 36864;
    const int bid = opaque_bid(), nblk = opaque_nblk();
    unsigned zz = 0u; asm volatile("" : "+v"(zz));
    const u32x4 zero4 = {zz, zz, zz, zz};
    for (int item = bid; item < 512; item += nblk) {
        const int kvh = item & 1, nb = (item >> 1) & 31, b = item >> 6;
        const int tok0 = b * S_ + nb * 128;
        __syncthreads();
        if (tid < 192) { const int row = tid / 3, part = tid - row * 3; *(LAS u32x4*)(Vt + row * 560 + 512 + part * 16) = zero4; }
#pragma unroll
        for (int i = 0; i < 4; ++i) { const int e = tid + 512 * i, kj = e >> 3, part = e & 7;
            u32x4 kv = zero4, vv = zero4;
            if (nb > 0 || kj >= 128) { const bf16_t* p = qkv + (size_t)(tok0 - 128 + kj) * 1280 + 1024 + kvh * 64 + part * 8; kv = *(const u32x4*)p; vv = *(const u32x4*)(p + 128); }
            *(LAS u32x4*)(Ks + kj * 144 + part * 16) = kv;
            LAS unsigned short* vt = (LAS unsigned short*)(Vt + (part * 8) * 560 + kj * 2);
            vt[0 * 280] = (unsigned short)(vv.x & 0xffffu); vt[1 * 280] = (unsigned short)(vv.x >> 16);
            vt[2 * 280] = (unsigned short)(vv.y & 0xffffu); vt[3 * 280] = (unsigned short)(vv.y >> 16);
            vt[4 * 280] = (unsigned short)(vv.z & 0xffffu); vt[5 * 280] = (unsigned short)(vv.z >> 16);
            vt[6 * 280] = (unsigned short)(vv.w & 0xffffu); vt[7 * 280] = (unsigned short)(vv.w >> 16); }
        __syncthreads();
        const int qi = 16 * wid + fr;
        const size_t tok = (size_t)(tok0 + qi);
        const bf16_t* qp = qkv + tok * 1280 + kvh * 512 + 8 * g;
        bf16x8 q0n = *(const bf16x8*)qp, q1n = *(const bf16x8*)(qp + 32);
#pragma unroll 1
        for (int hh = 0; hh < 8; ++hh) {
            const int h = kvh * 8 + hh;
            const bf16x8 q0 = q0n, q1 = q1n;
            if (hh < 7) { q0n = *(const bf16x8*)(qp + (hh + 1) * 64); q1n = *(const bf16x8*)(qp + (hh + 1) * 64 + 32); }
            f32x4 sc[10];
#pragma unroll
            for (int i = 0; i < 10; ++i) { sc[i] = (f32x4){0.f, 0.f, 0.f, 0.f};
                if (wid + i < 16) { const LAS unsigned char* kp = Ks + (16 * (wid + i) + fr) * 144 + g * 16;
                    const bf16x8 k0 = *(const LAS bf16x8*)kp, k1 = *(const LAS bf16x8*)(kp + 64);
                    sc[i] = __builtin_amdgcn_mfma_f32_16x16x32_bf16(k0, q0, sc[i], 0, 0, 0);
                    sc[i] = __builtin_amdgcn_mfma_f32_16x16x32_bf16(k1, q1, sc[i], 0, 0, 0); } }
            float mx = -1e30f;
#pragma unroll
            for (int i = 0; i < 10; ++i)
#pragma unroll
                for (int r = 0; r < 4; ++r) { const int kj = 16 * (wid + i) + 4 * g + r, d = qi + 128 - kj;
                    const bool valid = (d >= 0) && (d < 128) && (kj < 256) && (nb > 0 || kj >= 128);
                    const float s = valid ? sc[i][r] * 0.125f : -1e30f; sc[i][r] = s; mx = fmaxf(mx, s); }
            mx = fmaxf(mx, __shfl_xor(mx, 16)); mx = fmaxf(mx, __shfl_xor(mx, 32));
            const float sk = sinks[h]; mx = fmaxf(mx, sk);
            float sum = 0.f;
#pragma unroll
            for (int i = 0; i < 10; ++i)
#pragma unroll
                for (int r = 0; r < 4; ++r) { const float p = (sc[i][r] > -1e29f) ? __expf(sc[i][r] - mx) : 0.f; sc[i][r] = p; sum += p; }
            sum += __shfl_xor(sum, 16); sum += __shfl_xor(sum, 32);
            sum += __expf(sk - mx);
            const float inv = __builtin_amdgcn_rcpf(sum);
            f32x4 o[4];
#pragma unroll
            for (int dt = 0; dt < 4; ++dt) o[dt] = (f32x4){0.f, 0.f, 0.f, 0.f};
#pragma unroll
            for (int s2 = 0; s2 < 5; ++s2) {
                const u32x4 pw = {pk2(sc[2 * s2][0], sc[2 * s2][1]), pk2(sc[2 * s2][2], sc[2 * s2][3]), pk2(sc[2 * s2 + 1][0], sc[2 * s2 + 1][1]), pk2(sc[2 * s2 + 1][2], sc[2 * s2 + 1][3])};
                const bf16x8 pf = __builtin_bit_cast(bf16x8, pw);
#pragma unroll
                for (int dt = 0; dt < 4; ++dt) { const LAS unsigned char* vp = Vt + (16 * dt + fr) * 560 + (16 * (wid + 2 * s2) + 4 * g) * 2;
                    const u32x2 lo = *(const LAS u32x2*)vp, hi = *(const LAS u32x2*)(vp + 32);
                    const bf16x8 vf = __builtin_bit_cast(bf16x8, ((u32x4){lo.x, lo.y, hi.x, hi.y}));
                    o[dt] = __builtin_amdgcn_mfma_f32_16x16x32_bf16(vf, pf, o[dt], 0, 0, 0); } }
            bf16_t* op = out + tok * D_ + h * 64 + 4 * g;
#pragma unroll
            for (int dt = 0; dt < 4; ++dt) *(u32x2*)(op + 16 * dt) = pack4(o[dt] * inv);
        }
    }
    __syncthreads();
}


#define XB_TMO      128
#define XB_XCNT(j)  (256  + 64 * (j))
#define XB_XSUB(j)  (1280 + 64 * (j))
#define XB_XGEN(j)  (2304 + 64 * (j))
#define XB_TOP      3328
#define XB_TOPGEN   3392
#define XCD_BAR_WORDS 3456
#define XB_SPIN_CAP (1u << 20)
__device__ __forceinline__ unsigned xb_ld(unsigned* p)              { return __hip_atomic_load(p, __ATOMIC_RELAXED, __HIP_MEMORY_SCOPE_AGENT); }
__device__ __forceinline__ unsigned xb_add(unsigned* p, unsigned v) { return __hip_atomic_fetch_add(p, v, __ATOMIC_RELAXED, __HIP_MEMORY_SCOPE_AGENT); }
__device__ __forceinline__ unsigned xb_xcc_id() { return (unsigned)__builtin_amdgcn_s_getreg((3 << 11) | 20) & 0xFu; }
#define XB_SPIN(cond, bar) do { unsigned _sp = 0; while (cond) { __builtin_amdgcn_s_sleep(1); \
    if ((++_sp & 255u) == 0u) { if (xb_ld(&(bar)[XB_TMO])) break; if (_sp > XB_SPIN_CAP) { atomicAdd(&(bar)[XB_TMO], 1u); break; } } } } while (0)
__device__ __forceinline__ void xcd_barrier_complete(unsigned* bar, unsigned x, unsigned G, unsigned& nloc, unsigned& nx) {
    unsigned sum, cnt, mine, sp = 0u;
    for (;;) {
        sum = 0u; cnt = 0u; mine = 0u;
#pragma unroll
        for (unsigned j = 0; j < 16; ++j) { const unsigned c = xb_ld(&bar[XB_XCNT(j)]); sum += c; cnt += (c > 0u) ? 1u : 0u; mine = (j == x) ? c : mine; }
        if (sum == G) break;
        __builtin_amdgcn_s_sleep(1);
        if ((++sp & 255u) == 0u) { if (xb_ld(&bar[XB_TMO])) break; if (sp > XB_SPIN_CAP) { atomicAdd(&bar[XB_TMO], 1u); break; } }
    }
    nloc = mine > 0u ? mine : 1u; nx = cnt > 0u ? cnt : 1u;
}
__device__ __forceinline__ void xcd_barrier(unsigned* bar, volatile LAS unsigned* st) {
    asm volatile("s_waitcnt vmcnt(0)" ::: "memory");
    __syncthreads();
    if (threadIdx.x == 0) {
        __builtin_amdgcn_s_waitcnt(0);
        const unsigned x = xb_xcc_id();
        unsigned nloc = st[0], nx = st[1];
        if (nloc == 0u) { xcd_barrier_complete(bar, x, gridDim.x, nloc, nx); st[0] = nloc; st[1] = nx; }
        const unsigned old = xb_add(&bar[XB_XSUB(x)], 1u);
        const unsigned gen = old / nloc;
        if (old + 1u == (gen + 1u) * nloc) {
            __builtin_amdgcn_fence(__ATOMIC_RELEASE, "agent");
            asm volatile("s_waitcnt vmcnt(0)" ::: "memory");
            const unsigned og = xb_add(&bar[XB_TOP], 1u);
            const unsigned tg = og / nx;
            if (og + 1u == (tg + 1u) * nx) xb_add(&bar[XB_TOPGEN], 1u);
            else XB_SPIN(xb_ld(&bar[XB_TOPGEN]) == tg, bar);
            __builtin_amdgcn_fence(__ATOMIC_ACQUIRE, "agent");
            xb_add(&bar[XB_XGEN(x)], 1u);
            asm volatile("s_waitcnt vmcnt(0)" ::: "memory");
        } else {
            XB_SPIN(xb_ld(&bar[XB_XGEN(x)]) == gen, bar);
            __builtin_amdgcn_fence(__ATOMIC_ACQUIRE, "agent");
            asm volatile("s_waitcnt vmcnt(0)" ::: "memory");
        }
    }
    __syncthreads();
}

__device__ __forceinline__ void run_phase(const KArgs& a, int ph, LAS unsigned char* lds) {
    unsigned char* ws = a.ws;
    bf16_t* ABUF = (bf16_t*)(ws + OFF_ABUF); bf16_t* FBUF = (bf16_t*)(ws + OFF_FBUF); bf16_t* HBUF = (bf16_t*)(ws + OFF_HBUF);
    float* EBUF = (float*)(ws + OFF_EBUF);
    bf16_t* YBUF = HBUF;
    bf16_t* XPRE = HBUF + (size_t)T_ * D_;
    float* PBUF = (float*)(HBUF + (size_t)2 * T_ * D_);
    float* HEND = PBUF + 512 * 1024;
    bf16_t* XB = (bf16_t*)a.out;
    float* ROWSQ = (float*)(ws + OFF_RSQ);
    bf16_t* UBUF = FBUF;
    bf16_t* QKV = HBUF;
    bf16_t* AOUT = HBUF + (size_t)T_ * 1280;
    const float* lsl = (const float*)(ws + OFF_LSL);
    pg8::StaticOrder S;
    switch (ph) {
    case 0:
        phase_wconv(a, lds);
        phase_row(nullptr, nullptr, 0.f, a.in[0], ABUF, ROWSQ, nullptr, 0);
        break;
    case 1: case 11: case 14: case 21: {
        const int fi = ph == 1 ? 0 : ph == 11 ? 1 : ph == 14 ? 2 : 3;
        pg8::Gemm g{ABUF, (const bf16_t*)(ws + OFF_WT1 + fi * SZ_WT1), T_, 5632, 1024, 1024, 0};
        S.init(g.M, g.N, opaque_nblk(), opaque_bid());
        pg8::EpiG1 E{HBUF};
        pg8::gemm_phase(lds, g, S, E);
    } break;
    case 2: case 12: case 15: case 22: case 9: case 19: case 17: {
        pg8::Gemm g; pg8::EpiStore E;
        if (ph == 9)       { g = pg8::Gemm{YBUF, (const bf16_t*)(ws + OFF_WOUT), T_, 1024, 1024, 1024, 0}; E = pg8::EpiStore{FBUF, 1024, a.in[16]}; }
        else if (ph == 19) { g = pg8::Gemm{AOUT, (const bf16_t*)(ws + OFF_WO), T_, 1024, 1024, 1024, 0}; E = pg8::EpiStore{FBUF, 1024, a.in[21]}; }
        else if (ph == 17) { g = pg8::Gemm{ABUF, (const bf16_t*)(ws + OFF_WQKV), T_, 1280, 1024, 1024, 0}; E = pg8::EpiStore{QKV, 1280, a.in[18]}; }
        else { const int fi = ph == 2 ? 0 : ph == 12 ? 1 : ph == 15 ? 2 : 3;
            g = pg8::Gemm{HBUF, (const bf16_t*)(ws + OFF_WT2 + fi * SZ_WT2), T_, 1024, 2816, 2816, 0}; E = pg8::EpiStore{FBUF, 1024, nullptr}; }
        S.init(g.M, g.N, opaque_nblk(), opaque_bid());
        pg8::gemm_phase(lds, g, S, E);
    } break;
    case 3: case 10: case 13: case 16: case 20: case 23: {
        const float* nf = a.in[1]; const float* nm = a.in[2];
        const float* gpost; float scale = 0.5f;
        if (ph == 3)       { gpost = nf + 1 * 1024; }
        else if (ph == 10) { gpost = nm + 1 * 1024; scale = 1.0f; }
        else if (ph == 13) { gpost = nf + 3 * 1024; }
        else if (ph == 16) { gpost = nf + 5 * 1024; }
        else if (ph == 20) { gpost = nm + 3 * 1024; scale = 1.0f; }
        else               { gpost = nf + 7 * 1024; }
        phase_row(FBUF, gpost, scale, nullptr, ABUF, ROWSQ, a.out, ph == 23 ? 2 : 1);
    } break;
    case 4: {
        pg8::Gemm g{ABUF, (const bf16_t*)(ws + OFF_WIN), T_, 2048, 1024, 1024, 0};
        S.init(g.M, g.N, opaque_nblk(), opaque_bid());
        pg8::EpiGP E{YBUF, XPRE, a.in[7]};
        pg8::gemm_phase(lds, g, S, E);
    } break;
    case 5: phase_conv(XPRE, a.in[8], a.in[9], XB); break;
    case 6: {
        pg8::Gemm g{XB, (const bf16_t*)(ws + OFF_WGATE), T_, 2048, 256, 1024, 256};
        S.init(g.M, g.N, opaque_nblk(), opaque_bid());
        pg8::EpiGG E{XB, a.in[11], a.in[13], lsl, EBUF, UBUF};
        pg8::gemm_phase(lds, g, S, E);
    } break;
    case 7: phase_scan1(EBUF, UBUF, PBUF, HEND); break;
    case 8: phase_scan2(EBUF, UBUF, PBUF, HEND, YBUF); break;
    case 18: phase_attn(lds, QKV, a.in[19], AOUT); break;
    default: break;
    }
}

__global__ void __launch_bounds__(512, 2) mega_fwd(Args a_unused) {
    extern __shared__ __attribute__((aligned(16))) unsigned char shm[];
    LAS unsigned char* lds = (LAS unsigned char*)shm;
    cg::grid_group grid = cg::this_grid();
    KArgs* ap = (KArgs*)__builtin_amdgcn_kernarg_segment_ptr();
    const int ph_lo = ap->ph_lo, ph_hi = ap->ph_hi;
    volatile LAS unsigned* st = (volatile LAS unsigned*)(lds + LDS_GEMM);
    if (threadIdx.x == 0) { st[0] = 0u; st[1] = 0u; (void)xb_add((unsigned*)ap->ws + XB_XCNT(xb_xcc_id()), 1u); }
    __syncthreads();
    for (int ph = ph_lo; ph < ph_hi; ++ph) {
        KArgs* ap2 = ap; asm volatile("" : "+s"(ap2));
        run_phase(*ap2, ph, lds);
        if (ph + 1 < ph_hi) {
            if (ph == ph_lo) grid.sync();
            else xcd_barrier((unsigned*)ap2->ws, st);
        }
    }
}

extern "C" void kernel_launch(void* const* d_in, const int* in_sizes, int n_in, void* d_out, int out_size, void* d_ws, size_t ws_size, hipStream_t stream) {
    static int grid = 0;
    if (grid == 0) {
        if (n_in != 22 || out_size != T_ * D_ || ws_size < WS_END) { fprintf(stderr, "kernel_launch: unexpected shapes (n_in %d out %d ws %zu need %zu)\n", n_in, out_size, ws_size, (size_t)WS_END); grid = -1; return; }
        int dev = 0, cus = 0, per_cu = 0;
        hipGetDevice(&dev);
        hipDeviceGetAttribute(&cus, hipDeviceAttributeMultiprocessorCount, dev);
        if (hipFuncSetAttribute((const void*)mega_fwd, hipFuncAttributeMaxDynamicSharedMemorySize, LDS_BYTES) != hipSuccess) { fprintf(stderr, "kernel_launch: hipFuncSetAttribute failed\n"); grid = -1; return; }
        hipOccupancyMaxActiveBlocksPerMultiprocessor(&per_cu, (const void*)mega_fwd, 512, LDS_BYTES);
        if (per_cu < 1) { fprintf(stderr, "kernel_launch: occupancy query says %d blocks per CU\n", per_cu); grid = -1; return; }
        grid = cus;
    }
    if (grid < 0) return;
    if (hipMemsetAsync(d_ws, 0, 16384, stream) != hipSuccess) { fprintf(stderr, "kernel_launch: memset of the barrier words failed\n"); return; }
    Args a{};
    for (int i = 0; i < 22; ++i) a.in[i] = (const float*)d_in[i];
    a.out = (float*)d_out; a.ws = (unsigned char*)d_ws;
#if N_LAUNCH_PER_PHASE
    for (int ph = 0; ph < NPHASE; ++ph) {
        a.ph_lo = ph; a.ph_hi = ph + 1;
        void* args[] = {&a};
        hipError_t e = hipLaunchCooperativeKernel((const void*)mega_fwd, dim3(grid), dim3(512), args, LDS_BYTES, stream);
        if (e != hipSuccess) { fprintf(stderr, "cooperative launch failed: %s\n", hipGetErrorString(e)); break; }
    }
#else
    a.ph_lo = 0; a.ph_hi = NPHASE;
    void* args[] = {&a};
    hipError_t e = hipLaunchCooperativeKernel((const void*)mega_fwd, dim3(grid), dim3(512), args, LDS_BYTES, stream);
    if (e != hipSuccess) fprintf(stderr, "cooperative launch failed: %s (grid %d)\n", hipGetErrorString(e), grid);
#endif
}
```

```cpp
#include <hip/hip_runtime.h>
#include <hip/hip_cooperative_groups.h>
#include <cstdio>
namespace cg = cooperative_groups;

#define PROBE_MASK 0u
#define PROBE_CONST 0
#ifndef N_LAUNCH_PER_PHASE
#define N_LAUNCH_PER_PHASE 0
#endif

#define LAS __attribute__((address_space(3)))
typedef unsigned short bf16_t;
typedef short bf16x8 __attribute__((ext_vector_type(8)));
typedef float f32x4 __attribute__((ext_vector_type(4)));
typedef unsigned u32x4 __attribute__((ext_vector_type(4)));
typedef unsigned u32x2 __attribute__((ext_vector_type(2)));

constexpr int T_ = 32768, D_ = 1024, F_ = 2816, S_ = 4096;
constexpr int NPHASE = 24;
constexpr int LDS_GEMM = 131072;
constexpr int LDS_BYTES = LDS_GEMM + 16;

constexpr size_t OFF_LSL   = 16384;
constexpr size_t OFF_RSQ   = 32768;
constexpr size_t OFF_WT1   = 32768 + 131072;
constexpr size_t SZ_WT1    = (size_t)5632 * 1024 * 2;
constexpr size_t OFF_WT2   = OFF_WT1 + 4 * SZ_WT1;
constexpr size_t SZ_WT2    = (size_t)1024 * 2816 * 2;
constexpr size_t OFF_WIN   = OFF_WT2 + 4 * SZ_WT2;
constexpr size_t OFF_WGATE = OFF_WIN + (size_t)2048 * 1024 * 2;
constexpr size_t OFF_WOUT  = OFF_WGATE + (size_t)2048 * 256 * 2;
constexpr size_t OFF_WQKV  = OFF_WOUT + (size_t)1024 * 1024 * 2;
constexpr size_t OFF_WO    = OFF_WQKV + (size_t)1280 * 1024 * 2;
constexpr size_t OFF_ABUF  = OFF_WO + (size_t)1024 * 1024 * 2;
constexpr size_t SZ_TD2    = (size_t)T_ * D_ * 2;
constexpr size_t OFF_FBUF  = OFF_ABUF + SZ_TD2;
constexpr size_t OFF_HBUF  = OFF_FBUF + SZ_TD2;
constexpr size_t OFF_EBUF  = OFF_HBUF + (size_t)T_ * F_ * 2;
constexpr size_t WS_END    = OFF_EBUF + (size_t)T_ * D_ * 4;

struct Args {
    const float* in[22];
    float* out;
    unsigned char* ws;
    int ph_lo, ph_hi;
};

typedef const __attribute__((address_space(4))) Args KArgs;

__device__ __forceinline__ int opaque_bid() { int b = (int)blockIdx.x; asm volatile("" : "+s"(b)); return b; }
__device__ __forceinline__ int opaque_nblk() { int b = (int)gridDim.x; asm volatile("" : "+s"(b)); return b; }
__device__ __forceinline__ int opaque_lane() { unsigned z = 0u; asm volatile("" : "+v"(z)); return (int)__builtin_amdgcn_mbcnt_hi(~0u, __builtin_amdgcn_mbcnt_lo(~0u, z)); }
__device__ __forceinline__ int opaque_tid(int wv) { return (wv << 6) + opaque_lane(); }
typedef __bf16 bf16x2_t __attribute__((ext_vector_type(2)));
typedef float f32x2_t __attribute__((ext_vector_type(2)));
__device__ __forceinline__ unsigned pk2(float lo, float hi) { const f32x2_t v = {lo, hi}; const bf16x2_t b = __builtin_convertvector(v, bf16x2_t); return __builtin_bit_cast(unsigned, b); }
__device__ __forceinline__ float bflo(unsigned w) { return __uint_as_float(w << 16); }
__device__ __forceinline__ float bfhi(unsigned w) { return __uint_as_float(w & 0xffff0000u); }
__device__ __forceinline__ f32x4 unpack4(u32x2 w) { return (f32x4){bflo(w.x), bfhi(w.x), bflo(w.y), bfhi(w.y)}; }
__device__ __forceinline__ u32x2 pack4(f32x4 v) { return (u32x2){pk2(v[0], v[1]), pk2(v[2], v[3])}; }
__device__ __forceinline__ float shfl_xor_f(float v, int m, int lane) { return __int_as_float(__builtin_amdgcn_ds_bpermute((lane ^ m) << 2, __float_as_int(v))); }
__device__ __forceinline__ float wave_sum(float v, int lane) {
#pragma unroll
    for (int o = 32; o > 0; o >>= 1) v += shfl_xor_f(v, o, lane);
    return v;
}
__device__ __forceinline__ float sigmoidf_(float x) { return __builtin_amdgcn_rcpf(1.0f + __expf(-x)); }
__device__ __forceinline__ float gelu_tanh(float v) {
    const float z = 0.7978845608028654f * (v + 0.044715f * v * v * v);
    const float t = 1.0f - 2.0f * __builtin_amdgcn_rcpf(__expf(2.0f * z) + 1.0f);
    return 0.5f * v * (1.0f + t);
}

namespace pg8 {
constexpr int BM = 256, BK = 64, HALF = 128, HTB = HALF * BK * 2, NXCD = 8, WGM = 8;
__device__ __forceinline__ int lds_byte(int r, int c) { const int st = (r >> 4) * 2 + (c >> 5), rr = r & 15, cc = c & 31, ob = rr * 64 + cc * 2; return st * 1024 + (ob ^ (((ob >> 9) & 1) << 5)); }
__device__ __forceinline__ void stage_rc(int b, int& R, int& C) { const int st = b / 1024, sb = b % 1024, swz = sb ^ (((sb >> 9) & 1) << 5); R = (st >> 1) * 16 + swz / 64; C = (st & 1) * 32 + (swz % 64) / 2; }

struct Unit { int pm, pn; };
struct Gemm { const bf16_t* A; const bf16_t* Bt; int M, N, K, lda, headK; };

struct StaticOrder {
    int nM, nN, nwg, G, c;
    __device__ void init(int M, int N, int G_, int c_) { nM = M / BM; nN = N / BM; nwg = nM * nN; G = G_; c = c_; }
    __device__ bool next(int i, Unit& u) const {
        const long L = (long)i * G + c; if (L >= nwg) return false;
        int wgid = (int)L; { const int q = nwg / NXCD, r = nwg % NXCD, xcd = wgid % NXCD, off = wgid / NXCD; wgid = (xcd < r ? xcd * (q + 1) : r * (q + 1) + (xcd - r) * q) + off; }
        const int nig = WGM * nN, gid = wgid / nig, fm = gid * WGM, gsz = (nM - fm) < WGM ? (nM - fm) : WGM;
        u.pm = fm + ((wgid % nig) % gsz); u.pn = (wgid % nig) / gsz; return true;
    }
};

template <class Epi>
__device__ __forceinline__ void gemm_phase(LAS unsigned char* lds, const Gemm g, const StaticOrder& S, const Epi& E, int wv) {
    const int tid = opaque_tid(wv), wid = __builtin_amdgcn_readfirstlane(tid >> 6), lane = tid & 63, wr = wid >> 2, wc = wid & 3, fr = lane & 15, fq = lane >> 4;
    int K = g.K; asm volatile("" : "+s"(K));
    const int nt = K / BK;
    unsigned voffA[2], voffB[2];
#pragma unroll
    for (int i = 0; i < 2; ++i) { int R, C; stage_rc(tid * 16 + i * 8192, R, C);
        voffA[i] = (unsigned)(R * g.lda + C) * 2u; voffB[i] = (unsigned)(R * K + C) * 2u; }
    const size_t kstep = (size_t)(BK * 2);
    const size_t hstepA = (size_t)HALF * g.lda * 2, hstepB = (size_t)HALF * K * 2;
    const size_t tstepA = 2 * hstepA, tstepB = 2 * hstepB;
    const unsigned ldsw = (unsigned)wid * 1024u;
    const int aoff = lds_byte(wr * 64 + fr, fq * 8), boff = lds_byte(wc * 32 + fr, fq * 8);
#define PG8_SA(b, h) (((b) * 2 + (h)) * HTB)
#define PG8_SB(b, h) ((4 + (b) * 2 + (h)) * HTB)
#define PG8_STAGE(bufoff, gbase, voff) do { _Pragma("unroll") for (int _i = 0; _i < 2; ++_i) \
        __builtin_amdgcn_global_load_lds((const unsigned*)((const char*)(gbase) + (voff)[_i]), (LAS unsigned*)(lds + (bufoff) + ldsw + _i * 8192), 16, 0, 0); } while (0)
#define PG8_LDA(dst, b, h) do { _Pragma("unroll") for (int m = 0; m < 4; ++m) _Pragma("unroll") for (int k = 0; k < 2; ++k) dst[m][k] = *(const LAS bf16x8*)(lds + PG8_SA(b, h) + aoff + m * 2048 + k * 1024); } while (0)
#define PG8_LDB(dst, b, h) do { _Pragma("unroll") for (int n = 0; n < 2; ++n) _Pragma("unroll") for (int k = 0; k < 2; ++k) dst[n][k] = *(const LAS bf16x8*)(lds + PG8_SB(b, h) + boff + n * 2048 + k * 1024); } while (0)
#define PG8_MMA(ai, bj, At, Bt) do { __builtin_amdgcn_s_setprio(1); _Pragma("unroll") for (int m = 0; m < 4; ++m) _Pragma("unroll") for (int n = 0; n < 2; ++n) _Pragma("unroll") for (int k = 0; k < 2; ++k) \
        acc[ai][bj][m][n] = __builtin_amdgcn_mfma_f32_16x16x32_bf16(Bt[n][k], At[m][k], acc[ai][bj][m][n], 0, 0, 0); __builtin_amdgcn_s_setprio(0); } while (0)
#define PG8_WAIT_V(n) asm volatile("s_waitcnt vmcnt(" #n ")" ::: "memory")
#define PG8_WAIT_L(n) asm volatile("s_waitcnt lgkmcnt(" #n ")" ::: "memory")
#define PG8_BAR __builtin_amdgcn_s_barrier()
#define PG8_SCHED __builtin_amdgcn_sched_barrier(0)
    Unit cur, nxt; int ui = 0;
    if (!S.next(0, cur)) return;
    f32x4 acc[2][2][4][2];
#pragma unroll
    for (int a = 0; a < 2; ++a)
#pragma unroll
        for (int b = 0; b < 2; ++b)
#pragma unroll
            for (int m = 0; m < 4; ++m)
#pragma unroll
                for (int n = 0; n < 2; ++n) acc[a][b][m][n] = (f32x4){0.f, 0.f, 0.f, 0.f};
    bf16x8 At[4][2], B0[2][2], B1[2][2];
    constexpr int NDEF = Epi::NDEF;
    u32x4 pend[NDEF ? NDEF : 1]; char* pbase = nullptr; int npend = NDEF;
#define PG8_DEFER() do { if constexpr (NDEF > 0) { if (npend < NDEF) { E.store_slot(pend, pbase, npend); ++npend; } } } while (0)
    const char* cA = (const char*)g.A + (size_t)cur.pm * tstepA + (size_t)((cur.pn >> 1) * g.headK) * 2; const char* cB = (const char*)g.Bt + (size_t)cur.pn * tstepB;
    PG8_STAGE(PG8_SB(0, 0), cB, voffB); PG8_STAGE(PG8_SA(0, 0), cA, voffA); PG8_STAGE(PG8_SB(0, 1), cB + hstepB, voffB); PG8_STAGE(PG8_SA(0, 1), cA + hstepA, voffA);
    if (wr == 1) PG8_BAR;
    PG8_WAIT_V(4); PG8_BAR;
    PG8_STAGE(PG8_SB(1, 0), cB + kstep, voffB); PG8_STAGE(PG8_SA(1, 0), cA + kstep, voffA); PG8_STAGE(PG8_SB(1, 1), cB + hstepB + kstep, voffB);
    PG8_WAIT_V(6); PG8_BAR;
    for (;;) {
        const bool has_next = S.next(ui + 1, nxt);
        const char* nA = has_next ? (const char*)g.A + (size_t)nxt.pm * tstepA + (size_t)((nxt.pn >> 1) * g.headK) * 2 : cA; const char* nB = has_next ? (const char*)g.Bt + (size_t)nxt.pn * tstepB : cB;
        for (int t = 0; t < nt; t += 2) {
            const bool last = (t == nt - 2);
            const char* a1 = cA + (size_t)(t + 1) * kstep;
            const char* a2 = last ? nA : cA + (size_t)(t + 2) * kstep; const char* b2 = last ? nB : cB + (size_t)(t + 2) * kstep;
            const char* a3 = a2 + kstep; const char* b3 = b2 + kstep;
            PG8_LDB(B0, 0, 0); PG8_SCHED; PG8_LDA(At, 0, 0); PG8_STAGE(PG8_SA(1, 1), a1 + hstepA, voffA);
            PG8_WAIT_L(8); PG8_BAR; PG8_WAIT_L(0); PG8_MMA(0, 0, At, B0); PG8_BAR; PG8_SCHED;
            PG8_LDB(B1, 0, 1); PG8_STAGE(PG8_SB(0, 0), b2, voffB);
            PG8_BAR; PG8_WAIT_L(0); PG8_MMA(0, 1, At, B1); PG8_BAR;
            PG8_LDA(At, 0, 1); PG8_STAGE(PG8_SA(0, 0), a2, voffA);
            PG8_BAR; PG8_WAIT_L(0); PG8_MMA(1, 0, At, B0); PG8_BAR; PG8_SCHED;
            PG8_STAGE(PG8_SB(0, 1), b2 + hstepB, voffB);
            PG8_WAIT_V(6); PG8_BAR; PG8_DEFER(); PG8_MMA(1, 1, At, B1); PG8_BAR;
            PG8_LDB(B0, 1, 0); PG8_SCHED; PG8_LDA(At, 1, 0); PG8_STAGE(PG8_SA(0, 1), a2 + hstepA, voffA);
            PG8_WAIT_L(8); PG8_BAR; PG8_WAIT_L(0); PG8_MMA(0, 0, At, B0); PG8_BAR; PG8_SCHED;
            PG8_LDB(B1, 1, 1); PG8_STAGE(PG8_SB(1, 0), b3, voffB);
            PG8_BAR; PG8_WAIT_L(0); PG8_MMA(0, 1, At, B1); PG8_BAR;
            PG8_LDA(At, 1, 1); PG8_STAGE(PG8_SA(1, 0), a3, voffA);
            PG8_BAR; PG8_WAIT_L(0); PG8_MMA(1, 0, At, B0); PG8_BAR; PG8_SCHED;
            PG8_STAGE(PG8_SB(1, 1), b3 + hstepB, voffB);
            PG8_WAIT_V(6); PG8_BAR; PG8_DEFER(); PG8_MMA(1, 1, At, B1); PG8_BAR;
        }
        { const int ln = opaque_lane(), fr2 = ln & 15, fq2 = ln >> 4;
        if constexpr (NDEF > 0) {
#pragma unroll
            for (int s = 0; s < NDEF; ++s) if (s >= npend) E.store_fixed(pend, pbase, s);
            npend = NDEF;
            if (has_next) { E.pack(acc, cur, wr, wc, fr2, fq2, pend, pbase); npend = 0; }
            else E(acc, cur, wr, wc, fr2, fq2);
        } else E(acc, cur, wr, wc, fr2, fq2); }
        if (!has_next) break;
#pragma unroll
        for (int a = 0; a < 2; ++a)
#pragma unroll
            for (int b = 0; b < 2; ++b)
#pragma unroll
                for (int m = 0; m < 4; ++m)
#pragma unroll
                    for (int n = 0; n < 2; ++n) acc[a][b][m][n] = (f32x4){0.f, 0.f, 0.f, 0.f};
        cur = nxt; cA = nA; cB = nB; ++ui;
    }
    PG8_WAIT_V(0);
    if (wr == 0) PG8_BAR;
    PG8_BAR;
#undef PG8_DEFER
#undef PG8_SA
#undef PG8_SB
#undef PG8_STAGE
#undef PG8_LDA
#undef PG8_LDB
#undef PG8_MMA
#undef PG8_WAIT_V
#undef PG8_WAIT_L
#undef PG8_BAR
#undef PG8_SCHED
}

struct EpiStore {
    static constexpr int NDEF = 0;
    bf16_t* O; int ldc; const float* bias;
    __device__ __forceinline__ void operator()(const f32x4 (&acc)[2][2][4][2], const Unit& u, int wr, int wc, int fr, int fq) const {
        const int row0 = u.pm * BM + wr * 64 + fr, col0 = u.pn * BM + wc * 32 + 8 * fq;
        f32x4 bv[2][2];
#pragma unroll
        for (int bj = 0; bj < 2; ++bj)
#pragma unroll
            for (int n = 0; n < 2; ++n) bv[bj][n] = bias ? *(const f32x4*)(bias + col0 + bj * HALF + 4 * n) : (f32x4){0.f, 0.f, 0.f, 0.f};
#pragma unroll
        for (int ai = 0; ai < 2; ++ai)
#pragma unroll
            for (int m = 0; m < 4; ++m) { bf16_t* rowp = O + (size_t)(row0 + ai * HALF + m * 16) * ldc + col0;
#pragma unroll
                for (int bj = 0; bj < 2; ++bj) { const u32x2 lo = pack4(acc[ai][bj][m][0] + bv[bj][0]), hi = pack4(acc[ai][bj][m][1] + bv[bj][1]);
                    *(u32x4*)(rowp + bj * HALF) = (u32x4){lo.x, lo.y, hi.x, hi.y}; } }
    }
};
struct EpiG1 {
    static constexpr int NDEF = 3;
    bf16_t* H;
    __device__ __forceinline__ void pack(const f32x4 (&acc)[2][2][4][2], const Unit& u, int wr, int wc, int fr, int fq, u32x4 (&pend)[3], char*& pbase) const {
        pbase = (char*)(H + (size_t)(u.pm * BM + wr * 64 + fr) * F_ + (u.pn * 128 + wc * 32 + 8 * fq));
#pragma unroll
        for (int ai = 0; ai < 2; ++ai)
#pragma unroll
            for (int m = 0; m < 4; ++m) { f32x4 v[2];
#pragma unroll
                for (int bj = 0; bj < 2; ++bj) { const f32x4 gt = acc[ai][bj][m][0], up = acc[ai][bj][m][1];
#pragma unroll
                    for (int j = 0; j < 4; ++j) v[bj][j] = gt[j] * sigmoidf_(gt[j]) * up[j]; }
                const u32x2 lo = pack4(v[0]), hi = pack4(v[1]); const u32x4 w = {lo.x, lo.y, hi.x, hi.y};
                if (ai == 0 || m == 0) *(u32x4*)(pbase + (size_t)(128 * ai + 16 * m) * (F_ * 2)) = w; else pend[m - 1] = w; }
    }
    __device__ __forceinline__ void store_fixed(const u32x4 (&pend)[3], char* pbase, int s) const {
        *(u32x4*)(pbase + (size_t)(128 + 16 * (s + 1)) * (F_ * 2)) = pend[s];
    }
    __device__ __forceinline__ void store_slot(const u32x4 (&pend)[3], char* pbase, int s) const {
        switch (s) { case 0: store_fixed(pend, pbase, 0); break; case 1: store_fixed(pend, pbase, 1); break; default: store_fixed(pend, pbase, 2); break; }
    }
    __device__ __forceinline__ void operator()(const f32x4 (&acc)[2][2][4][2], const Unit& u, int wr, int wc, int fr, int fq) const {
        const int row0 = u.pm * BM + wr * 64 + fr, hc0 = u.pn * 128 + wc * 32 + 8 * fq;
#pragma unroll
        for (int ai = 0; ai < 2; ++ai)
#pragma unroll
            for (int m = 0; m < 4; ++m) { bf16_t* rowp = H + (size_t)(row0 + ai * HALF + m * 16) * F_ + hc0; f32x4 v[2];
#pragma unroll
                for (int bj = 0; bj < 2; ++bj) { const f32x4 gt = acc[ai][bj][m][0], up = acc[ai][bj][m][1];
#pragma unroll
                    for (int j = 0; j < 4; ++j) v[bj][j] = gt[j] * sigmoidf_(gt[j]) * up[j]; }
                const u32x2 lo = pack4(v[0]), hi = pack4(v[1]);
                *(u32x4*)rowp = (u32x4){lo.x, lo.y, hi.x, hi.y}; }
    }
};
struct EpiGP {
    static constexpr int NDEF = 0;
    bf16_t* Y; bf16_t* X; const float* bias;
    __device__ __forceinline__ void operator()(const f32x4 (&acc)[2][2][4][2], const Unit& u, int wr, int wc, int fr, int fq) const {
        const bool isy = u.pn < 4;
        const int row0 = u.pm * BM + wr * 64 + fr, col0 = (u.pn & 3) * BM + wc * 32 + 8 * fq, bcol0 = u.pn * BM + wc * 32 + 8 * fq;
        bf16_t* dst = isy ? Y : X;
        f32x4 bv[2][2];
#pragma unroll
        for (int bj = 0; bj < 2; ++bj)
#pragma unroll
            for (int n = 0; n < 2; ++n) bv[bj][n] = *(const f32x4*)(bias + bcol0 + bj * HALF + 4 * n);
#pragma unroll
        for (int ai = 0; ai < 2; ++ai)
#pragma unroll
            for (int m = 0; m < 4; ++m) { bf16_t* rowp = dst + (size_t)(row0 + ai * HALF + m * 16) * D_ + col0;
#pragma unroll
                for (int bj = 0; bj < 2; ++bj) { f32x4 v[2];
#pragma unroll
                    for (int n = 0; n < 2; ++n) { v[n] = acc[ai][bj][m][n] + bv[bj][n];
                        if (isy) {
#pragma unroll
                            for (int j = 0; j < 4; ++j) v[n][j] = gelu_tanh(v[n][j]); } }
                    const u32x2 lo = pack4(v[0]), hi = pack4(v[1]);
                    *(u32x4*)(rowp + bj * HALF) = (u32x4){lo.x, lo.y, hi.x, hi.y}; }
                __builtin_amdgcn_sched_barrier(0); }
    }
};
struct EpiGG {
    static constexpr int NDEF = 0;
    const bf16_t* XB; const float* ba; const float* bi; const float* lsl; bf16_t* Lout; bf16_t* Uout;
    __device__ __forceinline__ void operator()(const f32x4 (&acc)[2][2][4][2], const Unit& u, int wr, int wc, int fr, int fq) const {
        const unsigned ch0 = (unsigned)(u.pn * 128 + wc * 32 + 8 * fq);
        const unsigned o0 = (unsigned)(u.pm * BM + wr * 64 + fr) * (unsigned)D_ + ch0;
        u32x4 xw[2][4];
#pragma unroll
        for (int ai = 0; ai < 2; ++ai)
#pragma unroll
            for (int m = 0; m < 4; ++m) xw[ai][m] = *(const u32x4*)(XB + o0 + (unsigned)((ai * HALF + m * 16) * D_));
        f32x4 bav[2], biv[2], ls[2];
#pragma unroll
        for (int bj = 0; bj < 2; ++bj) { bav[bj] = *(const f32x4*)(ba + ch0 + 4 * bj); biv[bj] = *(const f32x4*)(bi + ch0 + 4 * bj); ls[bj] = *(const f32x4*)(lsl + ch0 + 4 * bj); }
        __builtin_amdgcn_sched_barrier(0);
#pragma unroll
        for (int ai = 0; ai < 2; ++ai)
#pragma unroll
            for (int m = 0; m < 4; ++m) { const unsigned o = o0 + (unsigned)((ai * HALF + m * 16) * D_);
                u32x2 lw[2], uw[2];
#pragma unroll
                for (int bj = 0; bj < 2; ++bj) {
                    const f32x4 xb = unpack4(bj ? (u32x2){xw[ai][m].z, xw[ai][m].w} : (u32x2){xw[ai][m].x, xw[ai][m].y});
                    const f32x4 pr = acc[ai][bj][m][0] + bav[bj], pi = acc[ai][bj][m][1] + biv[bj]; f32x4 av, uv;
#pragma unroll
                    for (int j = 0; j < 4; ++j) av[j] = sigmoidf_(pr[j]) * ls[bj][j];
                    lw[bj] = pack4(av); const f32x4 lr = unpack4(lw[bj]);
#pragma unroll
                    for (int j = 0; j < 4; ++j) { const float ig = sigmoidf_(pi[j]); const float a_ = __expf(lr[j]); uv[j] = __builtin_amdgcn_sqrtf(fmaxf(1.0f - a_ * a_, 0.f)) * ig * xb[j]; }
                    uw[bj] = pack4(uv); }
                *(u32x4*)(Lout + o) = (u32x4){lw[0].x, lw[0].y, lw[1].x, lw[1].y}; *(u32x4*)(Uout + o) = (u32x4){uw[0].x, uw[0].y, uw[1].x, uw[1].y};
                __builtin_amdgcn_sched_barrier(0); }
    }
};
}

__device__ void phase_wconv(const KArgs& a, LAS unsigned char* lds, int wv) {
    LAS float* tl = (LAS float*)lds;
    const int tid = opaque_tid(wv);
    unsigned char* ws = a.ws;
    const int bid = opaque_bid(), nblk = opaque_nblk();
    if (bid == nblk - 1) {
        float* lsl = (float*)(ws + OFF_LSL);
        for (int ch = tid; ch < 1024; ch += 512) { const float lam = a.in[14][ch]; const float x = __expf(-lam);
            const float l1p = x < 0.06f ? x * (1.0f - x * (0.5f - x * (0.33333334f - x * (0.25f - x * 0.2f)))) : __logf(1.0f + x);
            lsl[ch] = -8.0f * l1p; }
    }
    for (int tile = bid; tile < 2480; tile += nblk) {
        int t = tile, mode, K, ld; const float* s0; const float* s1 = nullptr; const float* gk = nullptr; bf16_t* dst;
        if (t < 1408)      { const int f = t / 352; t -= f * 352; mode = 1; K = 1024; ld = 2816; s0 = a.in[3] + (size_t)f * 1024 * 2816; s1 = a.in[4] + (size_t)f * 1024 * 2816; gk = a.in[1] + f * 2048; dst = (bf16_t*)(ws + OFF_WT1 + f * SZ_WT1); }
        else if (t < 2112) { t -= 1408; const int f = t / 176; t -= f * 176; mode = 0; K = 2816; ld = 1024; s0 = a.in[5] + (size_t)f * 2816 * 1024; dst = (bf16_t*)(ws + OFF_WT2 + f * SZ_WT2); }
        else if (t < 2240) { t -= 2112; mode = 0; K = 1024; ld = 2048; s0 = a.in[6]; gk = a.in[2]; dst = (bf16_t*)(ws + OFF_WIN); }
        else if (t < 2272) { t -= 2240; mode = 2; K = 256; ld = 256; s0 = a.in[10]; s1 = a.in[12]; dst = (bf16_t*)(ws + OFF_WGATE); }
        else if (t < 2336) { t -= 2272; mode = 0; K = 1024; ld = 1024; s0 = a.in[15]; dst = (bf16_t*)(ws + OFF_WOUT); }
        else if (t < 2416) { t -= 2336; mode = 0; K = 1024; ld = 1280; s0 = a.in[17]; gk = a.in[2] + 2048; dst = (bf16_t*)(ws + OFF_WQKV); }
        else               { t -= 2416; mode = 0; K = 1024; ld = 1024; s0 = a.in[20]; dst = (bf16_t*)(ws + OFF_WO); }
        const int nk = K >> 8, ct = t / nk, kt = t - ct * nk, k0 = kt * 256;
        const int cl = tid & 63, cw = tid >> 3;
        int rowl, roww;
        const float* cp;
        { const int slot = cl & 31, n = slot >> 4, fq = (slot >> 2) & 3, j = slot & 3;
          if (mode == 0) { rowl = ct * 64 + cl; cp = s0 + (rowl & ~31) + 8 * fq + 4 * n + j; }
          else { const int pn = ct >> 2, wc = ct & 3, bj = cl >> 5; rowl = 256 * pn + 128 * bj + 32 * wc + slot; const int hid = 128 * pn + 32 * wc + 8 * fq + 4 * bj + j;
              cp = (n ? s1 : s0) + (mode == 1 ? hid : (hid >> 8) * 65536 + (hid & 255)); } }
        if (mode == 0) roww = ct * 64 + cw; else roww = 256 * (ct >> 2) + 128 * (cw >> 5) + 32 * (ct & 3) + (cw & 31);
        (void)rowl;
        const int kl0 = tid >> 6;
        __syncthreads();
        if (gk) {
#pragma unroll
            for (int q = 0; q < 4; ++q)
#pragma unroll
                for (int i = 0; i < 8; ++i) { const int kl = kl0 + 8 * i, k = k0 + 64 * q + kl; tl[q * 4160 + cl * 65 + kl] = cp[(size_t)k * ld] * gk[k]; }
        } else {
#pragma unroll
            for (int q = 0; q < 4; ++q)
#pragma unroll
                for (int i = 0; i < 8; ++i) { const int kl = kl0 + 8 * i, k = k0 + 64 * q + kl; tl[q * 4160 + cl * 65 + kl] = cp[(size_t)k * ld]; }
        }
        __syncthreads();
        const int kc = tid & 7;
#pragma unroll
        for (int q = 0; q < 4; ++q) { const LAS float* tp = tl + q * 4160 + cw * 65 + 8 * kc;
            *(u32x4*)(dst + (size_t)roww * K + k0 + 64 * q + 8 * kc) = (u32x4){pk2(tp[0], tp[1]), pk2(tp[2], tp[3]), pk2(tp[4], tp[5]), pk2(tp[6], tp[7])}; }
    }
    __syncthreads();
}

__device__ void phase_row(const bf16_t* f, const float* gpost, float scale, const float* x, bf16_t* hb, float* rinv, float* out, int mode, int wv) {
    const int tid = opaque_tid(wv), lane = tid & 63, wid = tid >> 6;
    const int bid = opaque_bid(), nblk = opaque_nblk();
    f32x4 gp[4];
    if (mode != 0) {
#pragma unroll
        for (int i = 0; i < 4; ++i) gp[i] = *(const f32x4*)(gpost + 8 * lane + 512 * (i >> 1) + 4 * (i & 1));
    }
    const bool xl = (nblk == 256);
    const int rstart = xl ? 4096 * (bid & 7) + 128 * (bid >> 3) + 4 * wid : (bid * 8 + wid) * 4;
    const int rstep = xl ? 32 : nblk * 32, rend = xl ? 4096 * (bid & 7) + 128 * (bid >> 3) + 128 : T_;
    for (int row0 = rstart; row0 < rend; row0 += rstep) {
        f32x4 h[4][4]; u32x4 fw[4][2]; float ri[4];
        if (mode == 0) {
#pragma unroll
            for (int r = 0; r < 4; ++r)
#pragma unroll
                for (int i = 0; i < 4; ++i) h[r][i] = *(const f32x4*)(x + (size_t)(row0 + r) * D_ + 8 * lane + 512 * (i >> 1) + 4 * (i & 1));
        } else {
            u32x4 hw[4][2];
#pragma unroll
            for (int r = 0; r < 4; ++r) { ri[r] = rinv[row0 + r];
#pragma unroll
                for (int c = 0; c < 2; ++c) { hw[r][c] = *(const u32x4*)(hb + (size_t)(row0 + r) * D_ + 8 * lane + 512 * c); fw[r][c] = *(const u32x4*)(f + (size_t)(row0 + r) * D_ + 8 * lane + 512 * c); } }
#pragma unroll
            for (int r = 0; r < 4; ++r) {
                float ss = 0.f; f32x4 fv[4];
#pragma unroll
                for (int c = 0; c < 2; ++c) { fv[2 * c] = unpack4((u32x2){fw[r][c].x, fw[r][c].y}); fv[2 * c + 1] = unpack4((u32x2){fw[r][c].z, fw[r][c].w});
                    h[r][2 * c] = unpack4((u32x2){hw[r][c].x, hw[r][c].y}) * ri[r]; h[r][2 * c + 1] = unpack4((u32x2){hw[r][c].z, hw[r][c].w}) * ri[r]; }
#pragma unroll
                for (int i = 0; i < 4; ++i) ss += fv[i][0] * fv[i][0] + fv[i][1] * fv[i][1] + fv[i][2] * fv[i][2] + fv[i][3] * fv[i][3];
                ss = wave_sum(ss, lane);
                const float rs = rsqrtf(ss * (1.0f / 1024.0f) + 1e-6f) * scale;
#pragma unroll
                for (int i = 0; i < 4; ++i) h[r][i] += fv[i] * rs * gp[i];
            }
        }
        if (mode == 2) {
#pragma unroll
            for (int r = 0; r < 4; ++r)
#pragma unroll
                for (int i = 0; i < 4; ++i) *(f32x4*)(out + (size_t)(row0 + r) * D_ + 8 * lane + 512 * (i >> 1) + 4 * (i & 1)) = h[r][i];
        } else {
#pragma unroll
            for (int r = 0; r < 4; ++r) {
                float ss = 0.f;
#pragma unroll
                for (int i = 0; i < 4; ++i) ss += h[r][i][0] * h[r][i][0] + h[r][i][1] * h[r][i][1] + h[r][i][2] * h[r][i][2] + h[r][i][3] * h[r][i][3];
                ss = wave_sum(ss, lane);
                const float ms = ss * (1.0f / 1024.0f) + 1e-6f, rs = rsqrtf(ms);
#pragma unroll
                for (int c = 0; c < 2; ++c) { const u32x2 lo = pack4(h[r][2 * c] * rs), hi = pack4(h[r][2 * c + 1] * rs);
                    *(u32x4*)(hb + (size_t)(row0 + r) * D_ + 8 * lane + 512 * c) = (u32x4){lo.x, lo.y, hi.x, hi.y}; }
                if (lane == 0) rinv[row0 + r] = ms * rs;
            }
        }
    }
}

__device__ void phase_conv(const bf16_t* xpre, const float* cw, const float* cb, bf16_t* xb, int wv) {
    const int gt = opaque_bid() * 512 + opaque_tid(wv), nt = opaque_nblk() * 512;
    if (nt != 131072) {
        for (int idx = gt; idx < T_ * 128; idx += nt) {
            const int t = idx >> 7, ch = (idx & 127) * 8, s = t & (S_ - 1);
            f32x4 a0 = *(const f32x4*)(cb + ch), a1 = *(const f32x4*)(cb + ch + 4);
            u32x4 w[4];
#pragma unroll
            for (int k = 0; k < 4; ++k) { const int ds = 3 - k; w[k] = *(const u32x4*)(xpre + (size_t)(s >= ds ? t - ds : t) * D_ + ch); }
#pragma unroll
            for (int k = 0; k < 4; ++k) { const int ds = 3 - k; const float m = s >= ds ? 1.0f : 0.0f;
                const f32x4 w0 = *(const f32x4*)(cw + k * D_ + ch) * m, w1 = *(const f32x4*)(cw + k * D_ + ch + 4) * m;
                a0 += w0 * (f32x4){bflo(w[k].x), bfhi(w[k].x), bflo(w[k].y), bfhi(w[k].y)}; a1 += w1 * (f32x4){bflo(w[k].z), bfhi(w[k].z), bflo(w[k].w), bfhi(w[k].w)}; }
            *(u32x4*)(xb + (size_t)t * D_ + ch) = (u32x4){pk2(a0[0], a0[1]), pk2(a0[2], a0[3]), pk2(a1[0], a1[1]), pk2(a1[2], a1[3])};
        }
        return;
    }
    const int ch = (gt & 127) * 8, tb = gt >> 7;
    f32x4 wk0[4], wk1[4];
#pragma unroll
    for (int k = 0; k < 4; ++k) { wk0[k] = *(const f32x4*)(cw + k * D_ + ch); wk1[k] = *(const f32x4*)(cw + k * D_ + ch + 4); }
    const f32x4 b0 = *(const f32x4*)(cb + ch), b1 = *(const f32x4*)(cb + ch + 4);
#pragma unroll 1
    for (int it = 0; it < 32; it += 4) {
        u32x4 w[4][4];
#pragma unroll
        for (int q = 0; q < 4; ++q) { const int t = tb + 1024 * (it + q), s = t & (S_ - 1);
#pragma unroll
            for (int k = 0; k < 4; ++k) { const int ds = 3 - k; w[q][k] = *(const u32x4*)(xpre + (size_t)(s >= ds ? t - ds : t) * D_ + ch); } }
#pragma unroll
        for (int q = 0; q < 4; ++q) { const int t = tb + 1024 * (it + q), s = t & (S_ - 1);
            f32x4 a0 = b0, a1 = b1;
#pragma unroll
            for (int k = 0; k < 4; ++k) { const int ds = 3 - k; const float m = s >= ds ? 1.0f : 0.0f;
                a0 += (wk0[k] * m) * (f32x4){bflo(w[q][k].x), bfhi(w[q][k].x), bflo(w[q][k].y), bfhi(w[q][k].y)}; a1 += (wk1[k] * m) * (f32x4){bflo(w[q][k].z), bfhi(w[q][k].z), bflo(w[q][k].w), bfhi(w[q][k].w)}; }
            *(u32x4*)(xb + (size_t)t * D_ + ch) = (u32x4){pk2(a0[0], a0[1]), pk2(a0[2], a0[3]), pk2(a1[0], a1[1]), pk2(a1[2], a1[3])}; }
    }
}

__device__ __forceinline__ f32x4 exp4(f32x4 v) { return (f32x4){__expf(v[0]), __expf(v[1]), __expf(v[2]), __expf(v[3])}; }
__device__ void phase_scan1(const bf16_t* A, const bf16_t* U, float* P, float* H, int wv) {
    const int gt = opaque_bid() * 512 + opaque_tid(wv), nt = opaque_nblk() * 512;
    for (int it = gt; it < 131072; it += nt) {
        const int c4 = it & 255, bc = it >> 8;
        const size_t base = (size_t)bc * 64 * D_ + c4 * 4;
        f32x4 h = {0.f, 0.f, 0.f, 0.f}, p = {0.f, 0.f, 0.f, 0.f};
#pragma unroll 8
        for (int s = 0; s < 64; ++s) { const f32x4 lv = unpack4(*(const u32x2*)(A + base + (size_t)s * D_)); const f32x4 uv = unpack4(*(const u32x2*)(U + base + (size_t)s * D_)); h = exp4(lv) * h + uv; p += lv; }
        *(f32x4*)(P + (size_t)bc * D_ + c4 * 4) = exp4(p); *(f32x4*)(H + (size_t)bc * D_ + c4 * 4) = h;
    }
}
__device__ void phase_scan2(const bf16_t* A, const bf16_t* U, const float* P, const float* H, bf16_t* Y, int wv) {
    const int gt = opaque_bid() * 512 + opaque_tid(wv), nt = opaque_nblk() * 512;
    for (int it = gt; it < 131072; it += nt) {
        const int c4 = it & 255, bc = it >> 8, c = bc & 63, b0 = bc - c;
        f32x4 h = {0.f, 0.f, 0.f, 0.f};
#pragma unroll 4
        for (int cc = 0; cc < c; ++cc) { const size_t o = (size_t)(b0 + cc) * D_ + c4 * 4; const f32x4 pp = *(const f32x4*)(P + o), hh = *(const f32x4*)(H + o); h = pp * h + hh; }
        const size_t base = (size_t)bc * 64 * D_ + c4 * 4;
#pragma unroll 8
        for (int s = 0; s < 64; ++s) { const size_t o = base + (size_t)s * D_;
            const f32x4 lv = unpack4(*(const u32x2*)(A + o)); const f32x4 uv = unpack4(*(const u32x2*)(U + o)); const f32x4 yv = unpack4(*(const u32x2*)(Y + o));
            h = exp4(lv) * h + uv; *(u32x2*)(Y + o) = pack4(h * yv); }
    }
}

__device__ void phase_attn(LAS unsigned char* lds, const bf16_t* qkv, const float* sinks, bf16_t* out, int wv) {
    const int tid = opaque_tid(wv), lane = tid & 63, wid = __builtin_amdgcn_readfirstlane(tid >> 6), fr = lane & 15, g = lane >> 4;
    LAS unsigned char* Ks = lds;
    LAS unsigned char* Vt = lds + 36864;
    const int bid = opaque_bid(), nblk = opaque_nblk();
    unsigned zz = 0u; asm volatile("" : "+v"(zz));
    const u32x4 zero4 = {zz, zz, zz, zz};
    for (int item = bid; item < 512; item += nblk) {
        const int kvh = item & 1, nb = (item >> 1) & 31, b = item >> 6;
        const int tok0 = b * S_ + nb * 128;
        __syncthreads();
        if (tid < 192) { const int row = tid / 3, part = tid - row * 3; *(LAS u32x4*)(Vt + row * 560 + 512 + part * 16) = zero4; }
#pragma unroll
        for (int i = 0; i < 4; ++i) { const int e = tid + 512 * i, kj = e >> 3, part = e & 7;
            const bool live = (nb > 0 || kj >= 128);
            const bf16_t* p = qkv + (size_t)(live ? tok0 - 128 + kj : tok0) * 1280 + 1024 + kvh * 64 + part * 8;
            u32x4 kv = *(const u32x4*)p, vv = *(const u32x4*)(p + 128);
            if (!live) { kv = zero4; vv = zero4; }
            *(LAS u32x4*)(Ks + kj * 144 + part * 16) = kv;
            LAS unsigned short* vt = (LAS unsigned short*)(Vt + (part * 8) * 560 + kj * 2);
            vt[0 * 280] = (unsigned short)(vv.x & 0xffffu); vt[1 * 280] = (unsigned short)(vv.x >> 16);
            vt[2 * 280] = (unsigned short)(vv.y & 0xffffu); vt[3 * 280] = (unsigned short)(vv.y >> 16);
            vt[4 * 280] = (unsigned short)(vv.z & 0xffffu); vt[5 * 280] = (unsigned short)(vv.z >> 16);
            vt[6 * 280] = (unsigned short)(vv.w & 0xffffu); vt[7 * 280] = (unsigned short)(vv.w >> 16); }
        __syncthreads();
        const int qi = 16 * wid + fr;
        const size_t tok = (size_t)(tok0 + qi);
        const bf16_t* qp = qkv + tok * 1280 + kvh * 512 + 8 * g;
        bf16x8 q0n = *(const bf16x8*)qp, q1n = *(const bf16x8*)(qp + 32);
#pragma unroll 2
        for (int hh = 0; hh < 8; ++hh) {
            const int h = kvh * 8 + hh;
            const bf16x8 q0 = q0n, q1 = q1n;
            if (hh < 7) { q0n = *(const bf16x8*)(qp + (hh + 1) * 64); q1n = *(const bf16x8*)(qp + (hh + 1) * 64 + 32); }
            f32x4 sc[10];
#pragma unroll
            for (int i = 0; i < 10; ++i) { sc[i] = (f32x4){0.f, 0.f, 0.f, 0.f};
                if (i < 9 && wid + i < 16) { const LAS unsigned char* kp = Ks + (16 * (wid + i) + fr) * 144 + g * 16;
                    const bf16x8 k0 = *(const LAS bf16x8*)kp, k1 = *(const LAS bf16x8*)(kp + 64);
                    sc[i] = __builtin_amdgcn_mfma_f32_16x16x32_bf16(k0, q0, sc[i], 0, 0, 0);
                    sc[i] = __builtin_amdgcn_mfma_f32_16x16x32_bf16(k1, q1, sc[i], 0, 0, 0); } }
            float mx = -1e30f;
#pragma unroll
            for (int i = 0; i < 10; ++i) {
                const bool tile_ok = (i < 9) && (wid + i < 16) && (nb > 0 || wid + i >= 8);
#pragma unroll
                for (int r = 0; r < 4; ++r) { bool valid = tile_ok;
                    if (i == 0 || i == 8) { const int kj = 16 * (wid + i) + 4 * g + r, d = qi + 128 - kj; valid = valid && (d >= 0) && (d < 128); }
                    const float s = valid ? sc[i][r] * 0.125f : -1e30f; sc[i][r] = s; mx = fmaxf(mx, s); } }
            mx = fmaxf(mx, shfl_xor_f(mx, 16, lane)); mx = fmaxf(mx, shfl_xor_f(mx, 32, lane));
            const float sk = sinks[h]; mx = fmaxf(mx, sk);
            float sum = 0.f;
#pragma unroll
            for (int i = 0; i < 10; ++i)
#pragma unroll
                for (int r = 0; r < 4; ++r) { const float p = (sc[i][r] > -1e29f) ? __expf(sc[i][r] - mx) : 0.f; sc[i][r] = p; sum += p; }
            sum += shfl_xor_f(sum, 16, lane); sum += shfl_xor_f(sum, 32, lane);
            sum += __expf(sk - mx);
            const float inv = __builtin_amdgcn_rcpf(sum);
            f32x4 o[4];
#pragma unroll
            for (int dt = 0; dt < 4; ++dt) o[dt] = (f32x4){0.f, 0.f, 0.f, 0.f};
#pragma unroll
            for (int s2 = 0; s2 < 5; ++s2) {
                const u32x4 pw = {pk2(sc[2 * s2][0], sc[2 * s2][1]), pk2(sc[2 * s2][2], sc[2 * s2][3]), pk2(sc[2 * s2 + 1][0], sc[2 * s2 + 1][1]), pk2(sc[2 * s2 + 1][2], sc[2 * s2 + 1][3])};
                const bf16x8 pf = __builtin_bit_cast(bf16x8, pw);
#pragma unroll
                for (int dt = 0; dt < 4; ++dt) { const LAS unsigned char* vp = Vt + (16 * dt + fr) * 560 + (16 * (wid + 2 * s2) + 4 * g) * 2;
                    const u32x2 lo = *(const LAS u32x2*)vp, hi = *(const LAS u32x2*)(vp + 32);
                    const bf16x8 vf = __builtin_bit_cast(bf16x8, ((u32x4){lo.x, lo.y, hi.x, hi.y}));
                    o[dt] = __builtin_amdgcn_mfma_f32_16x16x32_bf16(vf, pf, o[dt], 0, 0, 0); } }
            bf16_t* op = out + tok * D_ + h * 64 + 4 * g;
#pragma unroll
            for (int dt = 0; dt < 4; ++dt) *(u32x2*)(op + 16 * dt) = pack4(o[dt] * inv);
        }
    }
    __syncthreads();
}


#define XB_TMO      128
#define XB_XCNT(j)  (256  + 64 * (j))
#define XB_XSUB(j)  (1280 + 64 * (j))
#define XB_XGEN(j)  (2304 + 64 * (j))
#define XB_TOP      3328
#define XB_TOPGEN   3392
#define XCD_BAR_WORDS 3456
#define XB_SPIN_CAP (1u << 20)
__device__ __forceinline__ unsigned xb_ld(unsigned* p)              { return __hip_atomic_load(p, __ATOMIC_RELAXED, __HIP_MEMORY_SCOPE_AGENT); }
__device__ __forceinline__ unsigned xb_add(unsigned* p, unsigned v) { return __hip_atomic_fetch_add(p, v, __ATOMIC_RELAXED, __HIP_MEMORY_SCOPE_AGENT); }
__device__ __forceinline__ unsigned xb_xcc_id() { return (unsigned)__builtin_amdgcn_s_getreg((3 << 11) | 20) & 0xFu; }
#define XB_SPIN(cond, bar) do { unsigned _sp = 0; while (cond) { __builtin_amdgcn_s_sleep(1); \
    if ((++_sp & 255u) == 0u) { if (xb_ld(&(bar)[XB_TMO])) break; if (_sp > XB_SPIN_CAP) { atomicAdd(&(bar)[XB_TMO], 1u); break; } } } } while (0)
__device__ __forceinline__ void xcd_barrier_complete(unsigned* bar, unsigned x, unsigned G, unsigned& nloc, unsigned& nx) {
    unsigned sum, cnt, mine, sp = 0u;
    for (;;) {
        sum = 0u; cnt = 0u; mine = 0u;
#pragma unroll
        for (unsigned j = 0; j < 16; ++j) { const unsigned c = xb_ld(&bar[XB_XCNT(j)]); sum += c; cnt += (c > 0u) ? 1u : 0u; mine = (j == x) ? c : mine; }
        if (sum == G) break;
        __builtin_amdgcn_s_sleep(1);
        if ((++sp & 255u) == 0u) { if (xb_ld(&bar[XB_TMO])) break; if (sp > XB_SPIN_CAP) { atomicAdd(&bar[XB_TMO], 1u); break; } }
    }
    nloc = mine > 0u ? mine : 1u; nx = cnt > 0u ? cnt : 1u;
}
__device__ __forceinline__ bool is_thread0(int wv) { return wv == 0 && opaque_lane() == 0; }
__device__ __forceinline__ void xcd_barrier(unsigned* bar, volatile LAS unsigned* st, int wv) {
    asm volatile("s_waitcnt vmcnt(0)" ::: "memory");
    __syncthreads();
    if (is_thread0(wv)) {
        __builtin_amdgcn_s_waitcnt(0);
        const unsigned x = xb_xcc_id();
        unsigned nloc = st[0], nx = st[1];
        if (nloc == 0u) { xcd_barrier_complete(bar, x, gridDim.x, nloc, nx); st[0] = nloc; st[1] = nx; }
        const unsigned old = xb_add(&bar[XB_XSUB(x)], 1u);
        const unsigned gen = old / nloc;
        if (old + 1u == (gen + 1u) * nloc) {
            __builtin_amdgcn_fence(__ATOMIC_RELEASE, "agent");
            asm volatile("s_waitcnt vmcnt(0)" ::: "memory");
            const unsigned og = xb_add(&bar[XB_TOP], 1u);
            const unsigned tg = og / nx;
            if (og + 1u == (tg + 1u) * nx) xb_add(&bar[XB_TOPGEN], 1u);
            else XB_SPIN(xb_ld(&bar[XB_TOPGEN]) == tg, bar);
            __builtin_amdgcn_fence(__ATOMIC_ACQUIRE, "agent");
            xb_add(&bar[XB_XGEN(x)], 1u);
            asm volatile("s_waitcnt vmcnt(0)" ::: "memory");
        } else {
            XB_SPIN(xb_ld(&bar[XB_XGEN(x)]) == gen, bar);
            __builtin_amdgcn_fence(__ATOMIC_ACQUIRE, "agent");
            asm volatile("s_waitcnt vmcnt(0)" ::: "memory");
        }
    }
    __syncthreads();
}

__device__ __forceinline__ void run_phase(const KArgs& a, int ph, LAS unsigned char* lds, int wv) {
    unsigned char* ws = a.ws;
    bf16_t* ABUF = (bf16_t*)(ws + OFF_ABUF); bf16_t* FBUF = (bf16_t*)(ws + OFF_FBUF); bf16_t* HBUF = (bf16_t*)(ws + OFF_HBUF);
    float* EBUF = (float*)(ws + OFF_EBUF);
    bf16_t* YBUF = HBUF;
    bf16_t* XPRE = HBUF + (size_t)T_ * D_;
    float* PBUF = (float*)(HBUF + (size_t)2 * T_ * D_);
    float* HEND = PBUF + 512 * 1024;
    bf16_t* XB = (bf16_t*)a.out;
    float* ROWSQ = (float*)(ws + OFF_RSQ);
    bf16_t* UBUF = FBUF;
    bf16_t* QKV = HBUF;
    bf16_t* AOUT = HBUF + (size_t)T_ * 1280;
    const float* lsl = (const float*)(ws + OFF_LSL);
    pg8::StaticOrder S;
    switch (ph) {
    case 0:
        phase_wconv(a, lds, wv);
        phase_row(nullptr, nullptr, 0.f, a.in[0], ABUF, ROWSQ, nullptr, 0, wv);
        break;
    case 1: case 11: case 14: case 21: {
        const int fi = ph == 1 ? 0 : ph == 11 ? 1 : ph == 14 ? 2 : 3;
        pg8::Gemm g{ABUF, (const bf16_t*)(ws + OFF_WT1 + fi * SZ_WT1), T_, 5632, 1024, 1024, 0};
        S.init(g.M, g.N, opaque_nblk(), opaque_bid());
        pg8::EpiG1 E{HBUF};
        pg8::gemm_phase(lds, g, S, E, wv);
    } break;
    case 2: case 12: case 15: case 22: case 9: case 19: case 17: {
        pg8::Gemm g; pg8::EpiStore E;
        if (ph == 9)       { g = pg8::Gemm{YBUF, (const bf16_t*)(ws + OFF_WOUT), T_, 1024, 1024, 1024, 0}; E = pg8::EpiStore{FBUF, 1024, a.in[16]}; }
        else if (ph == 19) { g = pg8::Gemm{AOUT, (const bf16_t*)(ws + OFF_WO), T_, 1024, 1024, 1024, 0}; E = pg8::EpiStore{FBUF, 1024, a.in[21]}; }
        else if (ph == 17) { g = pg8::Gemm{ABUF, (const bf16_t*)(ws + OFF_WQKV), T_, 1280, 1024, 1024, 0}; E = pg8::EpiStore{QKV, 1280, a.in[18]}; }
        else { const int fi = ph == 2 ? 0 : ph == 12 ? 1 : ph == 15 ? 2 : 3;
            g = pg8::Gemm{HBUF, (const bf16_t*)(ws + OFF_WT2 + fi * SZ_WT2), T_, 1024, 2816, 2816, 0}; E = pg8::EpiStore{FBUF, 1024, nullptr}; }
        S.init(g.M, g.N, opaque_nblk(), opaque_bid());
        pg8::gemm_phase(lds, g, S, E, wv);
    } break;
    case 3: case 10: case 13: case 16: case 20: case 23: {
        const float* nf = a.in[1]; const float* nm = a.in[2];
        const float* gpost; float scale = 0.5f;
        if (ph == 3)       { gpost = nf + 1 * 1024; }
        else if (ph == 10) { gpost = nm + 1 * 1024; scale = 1.0f; }
        else if (ph == 13) { gpost = nf + 3 * 1024; }
        else if (ph == 16) { gpost = nf + 5 * 1024; }
        else if (ph == 20) { gpost = nm + 3 * 1024; scale = 1.0f; }
        else               { gpost = nf + 7 * 1024; }
        phase_row(FBUF, gpost, scale, nullptr, ABUF, ROWSQ, a.out, ph == 23 ? 2 : 1, wv);
    } break;
    case 4: {
        pg8::Gemm g{ABUF, (const bf16_t*)(ws + OFF_WIN), T_, 2048, 1024, 1024, 0};
        S.init(g.M, g.N, opaque_nblk(), opaque_bid());
        pg8::EpiGP E{YBUF, XPRE, a.in[7]};
        pg8::gemm_phase(lds, g, S, E, wv);
    } break;
    case 5: phase_conv(XPRE, a.in[8], a.in[9], XB, wv); break;
    case 6: {
        pg8::Gemm g{XB, (const bf16_t*)(ws + OFF_WGATE), T_, 2048, 256, 1024, 256};
        S.init(g.M, g.N, opaque_nblk(), opaque_bid());
        pg8::EpiGG E{XB, a.in[11], a.in[13], lsl, (bf16_t*)EBUF, UBUF};
        pg8::gemm_phase(lds, g, S, E, wv);
    } break;
    case 7: phase_scan1((const bf16_t*)EBUF, UBUF, PBUF, HEND, wv); break;
    case 8: phase_scan2((const bf16_t*)EBUF, UBUF, PBUF, HEND, YBUF, wv); break;
    case 18: phase_attn(lds, QKV, a.in[19], AOUT, wv); break;
    default: break;
    }
}

__global__ void __launch_bounds__(512, 2) mega_fwd(Args a_unused) {
    extern __shared__ __attribute__((aligned(16))) unsigned char shm[];
    LAS unsigned char* lds = (LAS unsigned char*)shm;
    cg::grid_group grid = cg::this_grid();
    const int wv = __builtin_amdgcn_readfirstlane((int)threadIdx.x >> 6);
    KArgs* ap = (KArgs*)__builtin_amdgcn_kernarg_segment_ptr();
    const int ph_lo = ap->ph_lo, ph_hi = ap->ph_hi;
    volatile LAS unsigned* st = (volatile LAS unsigned*)(lds + LDS_GEMM);
    if (threadIdx.x == 0) { st[0] = 0u; st[1] = 0u; }
    __syncthreads();
#if PROBE_MASK || PROBE_CONST
    unsigned long long* stamps = (unsigned long long*)(ap->ws + 24576);
    const unsigned long long t_entry = __builtin_amdgcn_s_memrealtime();
    if (blockIdx.x == 0 && is_thread0(wv)) { stamps[0] = t_entry; __hip_atomic_store(stamps + 40, ~0ull, __ATOMIC_RELAXED, __HIP_MEMORY_SCOPE_AGENT); __hip_atomic_store(stamps + 41, 0ull, __ATOMIC_RELAXED, __HIP_MEMORY_SCOPE_AGENT); }
#endif
#if PROBE_MASK || PROBE_CONST
#define MK_STAMP(k) do { if (blockIdx.x == 0 && is_thread0(wv)) stamps[(k) + 1] = __builtin_amdgcn_s_memrealtime(); } while (0)
#else
#define MK_STAMP(k) do { } while (0)
#endif
#define MK_PHASE(k) do { if ((k) >= ph_lo && (k) < ph_hi) { KArgs* ap2 = ap; asm volatile("" : "+s"(ap2)); run_phase(*ap2, (k), lds, wv); \
        if ((k) + 1 < ph_hi) xcd_barrier((unsigned*)ap2->ws, st, wv); \
        MK_STAMP(k); } } while (0)
    if (ph_lo < 0) grid.sync();
    if (is_thread0(wv)) (void)xb_add((unsigned*)ap->ws + XB_XCNT(xb_xcc_id()), 1u);
    MK_PHASE(0);  MK_PHASE(1);  MK_PHASE(2);  MK_PHASE(3);  MK_PHASE(4);  MK_PHASE(5);  MK_PHASE(6);  MK_PHASE(7);
    MK_PHASE(8);  MK_PHASE(9);  MK_PHASE(10); MK_PHASE(11); MK_PHASE(12); MK_PHASE(13); MK_PHASE(14); MK_PHASE(15);
    MK_PHASE(16); MK_PHASE(17); MK_PHASE(18); MK_PHASE(19); MK_PHASE(20); MK_PHASE(21); MK_PHASE(22); MK_PHASE(23);
#undef MK_PHASE
#undef MK_STAMP
#if PROBE_MASK || PROBE_CONST
    if (PROBE_MASK & 0x1000000u) {
        if (is_thread0(wv)) { atomicMin(stamps + 40, t_entry); atomicMax(stamps + 41, (unsigned long long)__builtin_amdgcn_s_memrealtime()); }
        xcd_barrier((unsigned*)ap->ws, st, wv);
    }
    if (blockIdx.x == 0) {
        asm volatile("s_waitcnt vmcnt(0)" ::: "memory");
        __syncthreads();
        unsigned long long ticks = 0;
        for (int ph = 0; ph < NPHASE; ++ph) if ((PROBE_MASK >> ph) & 1u) ticks += stamps[ph + 1] - stamps[ph];
        if (PROBE_MASK & 0x1000000u) ticks = __hip_atomic_load(stamps + 41, __ATOMIC_RELAXED, __HIP_MEMORY_SCOPE_AGENT) - __hip_atomic_load(stamps + 40, __ATOMIC_RELAXED, __HIP_MEMORY_SCOPE_AGENT);
        int m = PROBE_CONST ? PROBE_CONST : (int)(ticks / 10ull);
        if (m > 32768) m = 32768;
        for (int i = opaque_tid(wv); i < m; i += 512) atomicAdd(ap->out + i, 0.05f);
    }
#endif
}

extern "C" void kernel_launch(void* const* d_in, const int* in_sizes, int n_in, void* d_out, int out_size, void* d_ws, size_t ws_size, hipStream_t stream) {
    static int grid = 0;
    if (grid == 0) {
        if (n_in != 22 || out_size != T_ * D_ || ws_size < WS_END) { fprintf(stderr, "kernel_launch: unexpected shapes (n_in %d out %d ws %zu need %zu)\n", n_in, out_size, ws_size, (size_t)WS_END); grid = -1; return; }
        int dev = 0, cus = 0, per_cu = 0;
        hipGetDevice(&dev);
        hipDeviceGetAttribute(&cus, hipDeviceAttributeMultiprocessorCount, dev);
        if (hipFuncSetAttribute((const void*)mega_fwd, hipFuncAttributeMaxDynamicSharedMemorySize, LDS_BYTES) != hipSuccess) { fprintf(stderr, "kernel_launch: hipFuncSetAttribute failed\n"); grid = -1; return; }
        hipOccupancyMaxActiveBlocksPerMultiprocessor(&per_cu, (const void*)mega_fwd, 512, LDS_BYTES);
        if (per_cu < 1) { fprintf(stderr, "kernel_launch: occupancy query says %d blocks per CU\n", per_cu); grid = -1; return; }
        grid = cus;
    }
    if (grid < 0) return;
    if (hipMemsetAsync(d_ws, 0, 16384, stream) != hipSuccess) { fprintf(stderr, "kernel_launch: memset of the barrier words failed\n"); return; }
    Args a{};
    for (int i = 0; i < 22; ++i) a.in[i] = (const float*)d_in[i];
    a.out = (float*)d_out; a.ws = (unsigned char*)d_ws;
#if N_LAUNCH_PER_PHASE
    for (int ph = 0; ph < NPHASE; ++ph) {
        a.ph_lo = ph; a.ph_hi = ph + 1;
        void* args[] = {&a};
        hipError_t e = hipLaunchCooperativeKernel((const void*)mega_fwd, dim3(grid), dim3(512), args, LDS_BYTES, stream);
        if (e != hipSuccess) { fprintf(stderr, "cooperative launch failed: %s\n", hipGetErrorString(e)); break; }
    }
#else
    a.ph_lo = 0; a.ph_hi = NPHASE;
    void* args[] = {&a};
    hipError_t e = hipLaunchCooperativeKernel((const void*)mega_fwd, dim3(grid), dim3(512), args, LDS_BYTES, stream);
    if (e != hipSuccess) fprintf(stderr, "cooperative launch failed: %s (grid %d)\n", hipGetErrorString(e), grid);
#endif
}
```

```cpp
#include <hip/hip_runtime.h>
#include <hip/hip_cooperative_groups.h>
#include <cstdio>
namespace cg = cooperative_groups;

#define PROBE_MASK 0u
#define PROBE_CONST 0
#ifndef N_LAUNCH_PER_PHASE
#define N_LAUNCH_PER_PHASE 0
#endif

#define LAS __attribute__((address_space(3)))
typedef unsigned short bf16_t;
typedef short bf16x8 __attribute__((ext_vector_type(8)));
typedef float f32x4 __attribute__((ext_vector_type(4)));
typedef unsigned u32x4 __attribute__((ext_vector_type(4)));
typedef unsigned u32x2 __attribute__((ext_vector_type(2)));

constexpr int T_ = 32768, D_ = 1024, F_ = 2816, S_ = 4096;
constexpr int NPHASE = 24;
constexpr int LDS_GEMM = 131072;
constexpr int LDS_BYTES = LDS_GEMM + 16;

constexpr size_t OFF_LSL   = 16384;
constexpr size_t OFF_RSQ   = 32768;
constexpr size_t OFF_WT1   = 32768 + 131072;
constexpr size_t SZ_WT1    = (size_t)5632 * 1024 * 2;
constexpr size_t OFF_WT2   = OFF_WT1 + 4 * SZ_WT1;
constexpr size_t SZ_WT2    = (size_t)1024 * 2816 * 2;
constexpr size_t OFF_WIN   = OFF_WT2 + 4 * SZ_WT2;
constexpr size_t OFF_WGATE = OFF_WIN + (size_t)2048 * 1024 * 2;
constexpr size_t OFF_WOUT  = OFF_WGATE + (size_t)2048 * 256 * 2;
constexpr size_t OFF_WQKV  = OFF_WOUT + (size_t)1024 * 1024 * 2;
constexpr size_t OFF_WO    = OFF_WQKV + (size_t)1280 * 1024 * 2;
constexpr size_t OFF_ABUF  = OFF_WO + (size_t)1024 * 1024 * 2;
constexpr size_t SZ_TD2    = (size_t)T_ * D_ * 2;
constexpr size_t OFF_FBUF  = OFF_ABUF + SZ_TD2;
constexpr size_t OFF_HBUF  = OFF_FBUF + SZ_TD2;
constexpr size_t OFF_EBUF  = OFF_HBUF + (size_t)T_ * F_ * 2;
constexpr size_t WS_END    = OFF_EBUF + (size_t)T_ * D_ * 4;

struct Args {
    const float* in[22];
    float* out;
    unsigned char* ws;
    int ph_lo, ph_hi;
};

typedef const __attribute__((address_space(4))) Args KArgs;

__device__ __forceinline__ int opaque_bid() { int b = (int)blockIdx.x; asm volatile("" : "+s"(b)); return b; }
__device__ __forceinline__ int xcd_major_bid(int bid, int nblk) { return (nblk & 7) == 0 ? (bid & 7) * (nblk >> 3) + (bid >> 3) : bid; }
__device__ __forceinline__ int opaque_nblk() { int b = (int)gridDim.x; asm volatile("" : "+s"(b)); return b; }
__device__ __forceinline__ int opaque_lane() { unsigned z = 0u; asm volatile("" : "+v"(z)); return (int)__builtin_amdgcn_mbcnt_hi(~0u, __builtin_amdgcn_mbcnt_lo(~0u, z)); }
__device__ __forceinline__ int opaque_tid(int wv) { return (wv << 6) + opaque_lane(); }
typedef __bf16 bf16x2_t __attribute__((ext_vector_type(2)));
typedef float f32x2_t __attribute__((ext_vector_type(2)));
__device__ __forceinline__ unsigned pk2(float lo, float hi) { const f32x2_t v = {lo, hi}; const bf16x2_t b = __builtin_convertvector(v, bf16x2_t); return __builtin_bit_cast(unsigned, b); }
__device__ __forceinline__ float bflo(unsigned w) { return __uint_as_float(w << 16); }
__device__ __forceinline__ float bfhi(unsigned w) { return __uint_as_float(w & 0xffff0000u); }
__device__ __forceinline__ f32x4 unpack4(u32x2 w) { return (f32x4){bflo(w.x), bfhi(w.x), bflo(w.y), bfhi(w.y)}; }
__device__ __forceinline__ u32x2 pack4(f32x4 v) { return (u32x2){pk2(v[0], v[1]), pk2(v[2], v[3])}; }
__device__ __forceinline__ float shfl_xor_f(float v, int m, int lane) { return __int_as_float(__builtin_amdgcn_ds_bpermute((lane ^ m) << 2, __float_as_int(v))); }
__device__ __forceinline__ float wave_sum(float v, int lane) {
#pragma unroll
    for (int o = 32; o > 0; o >>= 1) v += shfl_xor_f(v, o, lane);
    return v;
}
__device__ __forceinline__ float sigmoidf_(float x) { return __builtin_amdgcn_rcpf(1.0f + __expf(-x)); }
__device__ __forceinline__ float gelu_tanh(float v) {
    const float z = 0.7978845608028654f * (v + 0.044715f * v * v * v);
    const float t = 1.0f - 2.0f * __builtin_amdgcn_rcpf(__expf(2.0f * z) + 1.0f);
    return 0.5f * v * (1.0f + t);
}

namespace pg8 {
constexpr int BM = 256, BK = 64, HALF = 128, HTB = HALF * BK * 2, NXCD = 8, WGM = 8;
__device__ __forceinline__ int lds_byte(int r, int c) { const int st = (r >> 4) * 2 + (c >> 5), rr = r & 15, cc = c & 31, ob = rr * 64 + cc * 2; return st * 1024 + (ob ^ (((ob >> 9) & 1) << 5)); }
__device__ __forceinline__ void stage_rc(int b, int& R, int& C) { const int st = b / 1024, sb = b % 1024, swz = sb ^ (((sb >> 9) & 1) << 5); R = (st >> 1) * 16 + swz / 64; C = (st & 1) * 32 + (swz % 64) / 2; }

struct Unit { int pm, pn; };
struct Gemm { const bf16_t* A; const bf16_t* Bt; int M, N, K, lda, headK; };

struct StaticOrder {
    int nM, nN, nwg, G, c;
    __device__ void init(int M, int N, int G_, int c_) { nM = M / BM; nN = N / BM; nwg = nM * nN; G = G_; c = c_; }
    __device__ bool next(int i, Unit& u) const {
        const long L = (long)i * G + c; if (L >= nwg) return false;
        int wgid = (int)L; { const int q = nwg / NXCD, r = nwg % NXCD, xcd = wgid % NXCD, off = wgid / NXCD; wgid = (xcd < r ? xcd * (q + 1) : r * (q + 1) + (xcd - r) * q) + off; }
        const int nig = WGM * nN, gid = wgid / nig, fm = gid * WGM, gsz = (nM - fm) < WGM ? (nM - fm) : WGM;
        u.pm = fm + ((wgid % nig) % gsz); u.pn = (wgid % nig) / gsz; return true;
    }
};

template <class Epi>
__device__ __forceinline__ void gemm_phase(LAS unsigned char* lds, const Gemm g, const StaticOrder& S, const Epi& E, int wv) {
    const int tid = opaque_tid(wv), wid = __builtin_amdgcn_readfirstlane(tid >> 6), lane = tid & 63, wr = wid >> 2, wc = wid & 3, fr = lane & 15, fq = lane >> 4;
    int K = g.K; asm volatile("" : "+s"(K));
    const int nt = K / BK;
    unsigned voffA[2], voffB[2];
#pragma unroll
    for (int i = 0; i < 2; ++i) { int R, C; stage_rc(tid * 16 + i * 8192, R, C);
        voffA[i] = (unsigned)(R * g.lda + C) * 2u; voffB[i] = (unsigned)(R * K + C) * 2u; }
    const size_t kstep = (size_t)(BK * 2);
    const size_t hstepA = (size_t)HALF * g.lda * 2, hstepB = (size_t)HALF * K * 2;
    const size_t tstepA = 2 * hstepA, tstepB = 2 * hstepB;
    const unsigned ldsw = (unsigned)wid * 1024u;
    const int aoff = lds_byte(wr * 64 + fr, fq * 8), boff = lds_byte(wc * 32 + fr, fq * 8);
#define PG8_SA(b, h) (((b) * 2 + (h)) * HTB)
#define PG8_SB(b, h) ((4 + (b) * 2 + (h)) * HTB)
#define PG8_STAGE(bufoff, gbase, voff) do { _Pragma("unroll") for (int _i = 0; _i < 2; ++_i) \
        __builtin_amdgcn_global_load_lds((const unsigned*)((const char*)(gbase) + (voff)[_i]), (LAS unsigned*)(lds + (bufoff) + ldsw + _i * 8192), 16, 0, 0); } while (0)
#define PG8_LDA(dst, b, h) do { _Pragma("unroll") for (int m = 0; m < 4; ++m) _Pragma("unroll") for (int k = 0; k < 2; ++k) dst[m][k] = *(const LAS bf16x8*)(lds + PG8_SA(b, h) + aoff + m * 2048 + k * 1024); } while (0)
#define PG8_LDB(dst, b, h) do { _Pragma("unroll") for (int n = 0; n < 2; ++n) _Pragma("unroll") for (int k = 0; k < 2; ++k) dst[n][k] = *(const LAS bf16x8*)(lds + PG8_SB(b, h) + boff + n * 2048 + k * 1024); } while (0)
#define PG8_MMA(ai, bj, At, Bt) do { __builtin_amdgcn_s_setprio(1); _Pragma("unroll") for (int m = 0; m < 4; ++m) _Pragma("unroll") for (int n = 0; n < 2; ++n) _Pragma("unroll") for (int k = 0; k < 2; ++k) \
        acc[ai][bj][m][n] = __builtin_amdgcn_mfma_f32_16x16x32_bf16(Bt[n][k], At[m][k], acc[ai][bj][m][n], 0, 0, 0); __builtin_amdgcn_s_setprio(0); } while (0)
#define PG8_WAIT_V(n) asm volatile("s_waitcnt vmcnt(" #n ")" ::: "memory")
#define PG8_WAIT_L(n) asm volatile("s_waitcnt lgkmcnt(" #n ")" ::: "memory")
#define PG8_BAR __builtin_amdgcn_s_barrier()
#define PG8_SCHED __builtin_amdgcn_sched_barrier(0)
    Unit cur, nxt; int ui = 0;
    if (!S.next(0, cur)) return;
    f32x4 acc[2][2][4][2];
#pragma unroll
    for (int a = 0; a < 2; ++a)
#pragma unroll
        for (int b = 0; b < 2; ++b)
#pragma unroll
            for (int m = 0; m < 4; ++m)
#pragma unroll
                for (int n = 0; n < 2; ++n) acc[a][b][m][n] = (f32x4){0.f, 0.f, 0.f, 0.f};
    bf16x8 At[4][2], B0[2][2], B1[2][2];
    constexpr int NDEF = Epi::NDEF;
    u32x4 pend[NDEF ? NDEF : 1]; char* pbase = nullptr; int npend = NDEF;
#define PG8_DEFER() do { if constexpr (NDEF > 0) { if (npend < NDEF) { E.store_slot(pend, pbase, npend); ++npend; } } } while (0)
    const char* cA = (const char*)g.A + (size_t)cur.pm * tstepA + (size_t)((cur.pn >> 1) * g.headK) * 2; const char* cB = (const char*)g.Bt + (size_t)cur.pn * tstepB;
    PG8_STAGE(PG8_SB(0, 0), cB, voffB); PG8_STAGE(PG8_SA(0, 0), cA, voffA); PG8_STAGE(PG8_SB(0, 1), cB + hstepB, voffB); PG8_STAGE(PG8_SA(0, 1), cA + hstepA, voffA);
    if (wr == 1) PG8_BAR;
    PG8_WAIT_V(4); PG8_BAR;
    PG8_STAGE(PG8_SB(1, 0), cB + kstep, voffB); PG8_STAGE(PG8_SA(1, 0), cA + kstep, voffA); PG8_STAGE(PG8_SB(1, 1), cB + hstepB + kstep, voffB);
    PG8_WAIT_V(6); PG8_BAR;
    for (;;) {
        const bool has_next = S.next(ui + 1, nxt);
        const char* nA = has_next ? (const char*)g.A + (size_t)nxt.pm * tstepA + (size_t)((nxt.pn >> 1) * g.headK) * 2 : cA; const char* nB = has_next ? (const char*)g.Bt + (size_t)nxt.pn * tstepB : cB;
        for (int t = 0; t < nt; t += 2) {
            const bool last = (t == nt - 2);
            const char* a1 = cA + (size_t)(t + 1) * kstep;
            const char* a2 = last ? nA : cA + (size_t)(t + 2) * kstep; const char* b2 = last ? nB : cB + (size_t)(t + 2) * kstep;
            const char* a3 = a2 + kstep; const char* b3 = b2 + kstep;
            PG8_LDB(B0, 0, 0); PG8_SCHED; PG8_LDA(At, 0, 0); PG8_STAGE(PG8_SA(1, 1), a1 + hstepA, voffA);
            PG8_WAIT_L(8); PG8_BAR; PG8_WAIT_L(0); PG8_MMA(0, 0, At, B0); PG8_BAR; PG8_SCHED;
            PG8_LDB(B1, 0, 1); PG8_STAGE(PG8_SB(0, 0), b2, voffB);
            PG8_BAR; PG8_WAIT_L(0); PG8_MMA(0, 1, At, B1); PG8_BAR;
            PG8_LDA(At, 0, 1); PG8_STAGE(PG8_SA(0, 0), a2, voffA);
            PG8_BAR; PG8_WAIT_L(0); PG8_MMA(1, 0, At, B0); PG8_BAR; PG8_SCHED;
            PG8_STAGE(PG8_SB(0, 1), b2 + hstepB, voffB);
            PG8_WAIT_V(6); PG8_BAR; PG8_DEFER(); PG8_MMA(1, 1, At, B1); PG8_BAR;
            PG8_LDB(B0, 1, 0); PG8_SCHED; PG8_LDA(At, 1, 0); PG8_STAGE(PG8_SA(0, 1), a2 + hstepA, voffA);
            PG8_WAIT_L(8); PG8_BAR; PG8_WAIT_L(0); PG8_MMA(0, 0, At, B0); PG8_BAR; PG8_SCHED;
            PG8_LDB(B1, 1, 1); PG8_STAGE(PG8_SB(1, 0), b3, voffB);
            PG8_BAR; PG8_WAIT_L(0); PG8_MMA(0, 1, At, B1); PG8_BAR;
            PG8_LDA(At, 1, 1); PG8_STAGE(PG8_SA(1, 0), a3, voffA);
            PG8_BAR; PG8_WAIT_L(0); PG8_MMA(1, 0, At, B0); PG8_BAR; PG8_SCHED;
            PG8_STAGE(PG8_SB(1, 1), b3 + hstepB, voffB);
            PG8_WAIT_V(6); PG8_BAR; PG8_DEFER(); PG8_MMA(1, 1, At, B1); PG8_BAR;
        }
        { const int ln = opaque_lane(), fr2 = ln & 15, fq2 = ln >> 4;
        if constexpr (NDEF > 0) {
#pragma unroll
            for (int s = 0; s < NDEF; ++s) if (s >= npend) E.store_fixed(pend, pbase, s);
            npend = NDEF;
            if (has_next) { E.pack(acc, cur, wr, wc, fr2, fq2, pend, pbase); npend = 0; }
            else E(acc, cur, wr, wc, fr2, fq2);
        } else E(acc, cur, wr, wc, fr2, fq2); }
        if (!has_next) break;
#pragma unroll
        for (int a = 0; a < 2; ++a)
#pragma unroll
            for (int b = 0; b < 2; ++b)
#pragma unroll
                for (int m = 0; m < 4; ++m)
#pragma unroll
                    for (int n = 0; n < 2; ++n) acc[a][b][m][n] = (f32x4){0.f, 0.f, 0.f, 0.f};
        cur = nxt; cA = nA; cB = nB; ++ui;
    }
    PG8_WAIT_V(0);
    if (wr == 0) PG8_BAR;
    PG8_BAR;
#undef PG8_DEFER
#undef PG8_SA
#undef PG8_SB
#undef PG8_STAGE
#undef PG8_LDA
#undef PG8_LDB
#undef PG8_MMA
#undef PG8_WAIT_V
#undef PG8_WAIT_L
#undef PG8_BAR
#undef PG8_SCHED
}

struct EpiStore {
    static constexpr int NDEF = 0;
    bf16_t* O; int ldc; const float* bias;
    __device__ __forceinline__ void operator()(const f32x4 (&acc)[2][2][4][2], const Unit& u, int wr, int wc, int fr, int fq) const {
        const int row0 = u.pm * BM + wr * 64 + fr, col0 = u.pn * BM + wc * 32 + 8 * fq;
        f32x4 bv[2][2];
#pragma unroll
        for (int bj = 0; bj < 2; ++bj)
#pragma unroll
            for (int n = 0; n < 2; ++n) bv[bj][n] = bias ? *(const f32x4*)(bias + col0 + bj * HALF + 4 * n) : (f32x4){0.f, 0.f, 0.f, 0.f};
#pragma unroll
        for (int ai = 0; ai < 2; ++ai)
#pragma unroll
            for (int m = 0; m < 4; ++m) { bf16_t* rowp = O + (size_t)(row0 + ai * HALF + m * 16) * ldc + col0;
#pragma unroll
                for (int bj = 0; bj < 2; ++bj) { const u32x2 lo = pack4(acc[ai][bj][m][0] + bv[bj][0]), hi = pack4(acc[ai][bj][m][1] + bv[bj][1]);
                    *(u32x4*)(rowp + bj * HALF) = (u32x4){lo.x, lo.y, hi.x, hi.y}; } }
    }
};
struct EpiG1 {
    static constexpr int NDEF = 3;
    bf16_t* H;
    __device__ __forceinline__ void pack(const f32x4 (&acc)[2][2][4][2], const Unit& u, int wr, int wc, int fr, int fq, u32x4 (&pend)[3], char*& pbase) const {
        pbase = (char*)(H + (size_t)(u.pm * BM + wr * 64 + fr) * F_ + (u.pn * 128 + wc * 32 + 8 * fq));
#pragma unroll
        for (int ai = 0; ai < 2; ++ai)
#pragma unroll
            for (int m = 0; m < 4; ++m) { f32x4 v[2];
#pragma unroll
                for (int bj = 0; bj < 2; ++bj) { const f32x4 gt = acc[ai][bj][m][0], up = acc[ai][bj][m][1];
#pragma unroll
                    for (int j = 0; j < 4; ++j) v[bj][j] = gt[j] * sigmoidf_(gt[j]) * up[j]; }
                const u32x2 lo = pack4(v[0]), hi = pack4(v[1]); const u32x4 w = {lo.x, lo.y, hi.x, hi.y};
                if (ai == 0 || m == 0) *(u32x4*)(pbase + (size_t)(128 * ai + 16 * m) * (F_ * 2)) = w; else pend[m - 1] = w; }
    }
    __device__ __forceinline__ void store_fixed(const u32x4 (&pend)[3], char* pbase, int s) const {
        *(u32x4*)(pbase + (size_t)(128 + 16 * (s + 1)) * (F_ * 2)) = pend[s];
    }
    __device__ __forceinline__ void store_slot(const u32x4 (&pend)[3], char* pbase, int s) const {
        switch (s) { case 0: store_fixed(pend, pbase, 0); break; case 1: store_fixed(pend, pbase, 1); break; default: store_fixed(pend, pbase, 2); break; }
    }
    __device__ __forceinline__ void operator()(const f32x4 (&acc)[2][2][4][2], const Unit& u, int wr, int wc, int fr, int fq) const {
        const int row0 = u.pm * BM + wr * 64 + fr, hc0 = u.pn * 128 + wc * 32 + 8 * fq;
#pragma unroll
        for (int ai = 0; ai < 2; ++ai)
#pragma unroll
            for (int m = 0; m < 4; ++m) { bf16_t* rowp = H + (size_t)(row0 + ai * HALF + m * 16) * F_ + hc0; f32x4 v[2];
#pragma unroll
                for (int bj = 0; bj < 2; ++bj) { const f32x4 gt = acc[ai][bj][m][0], up = acc[ai][bj][m][1];
#pragma unroll
                    for (int j = 0; j < 4; ++j) v[bj][j] = gt[j] * sigmoidf_(gt[j]) * up[j]; }
                const u32x2 lo = pack4(v[0]), hi = pack4(v[1]);
                *(u32x4*)rowp = (u32x4){lo.x, lo.y, hi.x, hi.y}; }
    }
};
struct EpiGP {
    static constexpr int NDEF = 0;
    bf16_t* Y; bf16_t* X; const float* bias;
    __device__ __forceinline__ void operator()(const f32x4 (&acc)[2][2][4][2], const Unit& u, int wr, int wc, int fr, int fq) const {
        const bool isy = u.pn < 4;
        const int row0 = u.pm * BM + wr * 64 + fr, col0 = (u.pn & 3) * BM + wc * 32 + 8 * fq, bcol0 = u.pn * BM + wc * 32 + 8 * fq;
        bf16_t* dst = isy ? Y : X;
        f32x4 bv[2][2];
#pragma unroll
        for (int bj = 0; bj < 2; ++bj)
#pragma unroll
            for (int n = 0; n < 2; ++n) bv[bj][n] = *(const f32x4*)(bias + bcol0 + bj * HALF + 4 * n);
#pragma unroll
        for (int ai = 0; ai < 2; ++ai)
#pragma unroll
            for (int m = 0; m < 4; ++m) { bf16_t* rowp = dst + (size_t)(row0 + ai * HALF + m * 16) * D_ + col0;
#pragma unroll
                for (int bj = 0; bj < 2; ++bj) { f32x4 v[2];
#pragma unroll
                    for (int n = 0; n < 2; ++n) { v[n] = acc[ai][bj][m][n] + bv[bj][n];
                        if (isy) {
#pragma unroll
                            for (int j = 0; j < 4; ++j) v[n][j] = gelu_tanh(v[n][j]); } }
                    const u32x2 lo = pack4(v[0]), hi = pack4(v[1]);
                    *(u32x4*)(rowp + bj * HALF) = (u32x4){lo.x, lo.y, hi.x, hi.y}; }
                __builtin_amdgcn_sched_barrier(0); }
    }
};
struct EpiGG {
    static constexpr int NDEF = 0;
    const bf16_t* XB; const float* ba; const float* bi; const float* lsl; bf16_t* Lout; bf16_t* Uout;
    __device__ __forceinline__ void operator()(const f32x4 (&acc)[2][2][4][2], const Unit& u, int wr, int wc, int fr, int fq) const {
        const unsigned ch0 = (unsigned)(u.pn * 128 + wc * 32 + 8 * fq);
        const unsigned o0 = (unsigned)(u.pm * BM + wr * 64 + fr) * (unsigned)D_ + ch0;
        u32x4 xw[2][4];
#pragma unroll
        for (int ai = 0; ai < 2; ++ai)
#pragma unroll
            for (int m = 0; m < 4; ++m) xw[ai][m] = *(const u32x4*)(XB + o0 + (unsigned)((ai * HALF + m * 16) * D_));
        f32x4 bav[2], biv[2], ls[2];
#pragma unroll
        for (int bj = 0; bj < 2; ++bj) { bav[bj] = *(const f32x4*)(ba + ch0 + 4 * bj); biv[bj] = *(const f32x4*)(bi + ch0 + 4 * bj); ls[bj] = *(const f32x4*)(lsl + ch0 + 4 * bj); }
        __builtin_amdgcn_sched_barrier(0);
#pragma unroll
        for (int ai = 0; ai < 2; ++ai)
#pragma unroll
            for (int m = 0; m < 4; ++m) { const unsigned o = o0 + (unsigned)((ai * HALF + m * 16) * D_);
                u32x2 lw[2], uw[2];
#pragma unroll
                for (int bj = 0; bj < 2; ++bj) {
                    const f32x4 xb = unpack4(bj ? (u32x2){xw[ai][m].z, xw[ai][m].w} : (u32x2){xw[ai][m].x, xw[ai][m].y});
                    const f32x4 pr = acc[ai][bj][m][0] + bav[bj], pi = acc[ai][bj][m][1] + biv[bj]; f32x4 av, uv;
#pragma unroll
                    for (int j = 0; j < 4; ++j) av[j] = sigmoidf_(pr[j]) * ls[bj][j];
                    lw[bj] = pack4(av); const f32x4 lr = unpack4(lw[bj]);
#pragma unroll
                    for (int j = 0; j < 4; ++j) { const float ig = sigmoidf_(pi[j]); const float a_ = __expf(lr[j]); uv[j] = __builtin_amdgcn_sqrtf(fmaxf(1.0f - a_ * a_, 0.f)) * ig * xb[j]; }
                    uw[bj] = pack4(uv); }
                *(u32x4*)(Lout + o) = (u32x4){lw[0].x, lw[0].y, lw[1].x, lw[1].y}; *(u32x4*)(Uout + o) = (u32x4){uw[0].x, uw[0].y, uw[1].x, uw[1].y};
                __builtin_amdgcn_sched_barrier(0); }
    }
};
}

__device__ void phase_wconv(const KArgs& a, LAS unsigned char* lds, int wv) {
    LAS float* tl = (LAS float*)lds;
    const int tid = opaque_tid(wv);
    unsigned char* ws = a.ws;
    const int bid = opaque_bid(), nblk = opaque_nblk();
    if (bid == nblk - 1) {
        float* lsl = (float*)(ws + OFF_LSL);
        for (int ch = tid; ch < 1024; ch += 512) { const float lam = a.in[14][ch]; const float x = __expf(-lam);
            const float l1p = x < 0.06f ? x * (1.0f - x * (0.5f - x * (0.33333334f - x * (0.25f - x * 0.2f)))) : __logf(1.0f + x);
            lsl[ch] = -8.0f * l1p; }
    }
    for (int tile = bid; tile < 2480; tile += nblk) {
        int t = tile, mode, K, ld; const float* s0; const float* s1 = nullptr; const float* gk = nullptr; bf16_t* dst;
        if (t < 1408)      { const int f = t / 352; t -= f * 352; mode = 1; K = 1024; ld = 2816; s0 = a.in[3] + (size_t)f * 1024 * 2816; s1 = a.in[4] + (size_t)f * 1024 * 2816; gk = a.in[1] + f * 2048; dst = (bf16_t*)(ws + OFF_WT1 + f * SZ_WT1); }
        else if (t < 2112) { t -= 1408; const int f = t / 176; t -= f * 176; mode = 0; K = 2816; ld = 1024; s0 = a.in[5] + (size_t)f * 2816 * 1024; dst = (bf16_t*)(ws + OFF_WT2 + f * SZ_WT2); }
        else if (t < 2240) { t -= 2112; mode = 0; K = 1024; ld = 2048; s0 = a.in[6]; gk = a.in[2]; dst = (bf16_t*)(ws + OFF_WIN); }
        else if (t < 2272) { t -= 2240; mode = 2; K = 256; ld = 256; s0 = a.in[10]; s1 = a.in[12]; dst = (bf16_t*)(ws + OFF_WGATE); }
        else if (t < 2336) { t -= 2272; mode = 0; K = 1024; ld = 1024; s0 = a.in[15]; dst = (bf16_t*)(ws + OFF_WOUT); }
        else if (t < 2416) { t -= 2336; mode = 0; K = 1024; ld = 1280; s0 = a.in[17]; gk = a.in[2] + 2048; dst = (bf16_t*)(ws + OFF_WQKV); }
        else               { t -= 2416; mode = 0; K = 1024; ld = 1024; s0 = a.in[20]; dst = (bf16_t*)(ws + OFF_WO); }
        const int nk = K >> 8, ct = t / nk, kt = t - ct * nk, k0 = kt * 256;
        const int cl = tid & 63, cw = tid >> 3;
        int rowl, roww;
        const float* cp;
        { const int slot = cl & 31, n = slot >> 4, fq = (slot >> 2) & 3, j = slot & 3;
          if (mode == 0) { rowl = ct * 64 + cl; cp = s0 + (rowl & ~31) + 8 * fq + 4 * n + j; }
          else { const int pn = ct >> 2, wc = ct & 3, bj = cl >> 5; rowl = 256 * pn + 128 * bj + 32 * wc + slot; const int hid = 128 * pn + 32 * wc + 8 * fq + 4 * bj + j;
              cp = (n ? s1 : s0) + (mode == 1 ? hid : (hid >> 8) * 65536 + (hid & 255)); } }
        if (mode == 0) roww = ct * 64 + cw; else roww = 256 * (ct >> 2) + 128 * (cw >> 5) + 32 * (ct & 3) + (cw & 31);
        (void)rowl;
        const int kl0 = tid >> 6;
        __syncthreads();
        if (gk) {
#pragma unroll
            for (int q = 0; q < 4; ++q)
#pragma unroll
                for (int i = 0; i < 8; ++i) { const int kl = kl0 + 8 * i, k = k0 + 64 * q + kl; tl[q * 4160 + cl * 65 + kl] = cp[(size_t)k * ld] * gk[k]; }
        } else {
#pragma unroll
            for (int q = 0; q < 4; ++q)
#pragma unroll
                for (int i = 0; i < 8; ++i) { const int kl = kl0 + 8 * i, k = k0 + 64 * q + kl; tl[q * 4160 + cl * 65 + kl] = cp[(size_t)k * ld]; }
        }
        __syncthreads();
        const int kc = tid & 7;
#pragma unroll
        for (int q = 0; q < 4; ++q) { const LAS float* tp = tl + q * 4160 + cw * 65 + 8 * kc;
            *(u32x4*)(dst + (size_t)roww * K + k0 + 64 * q + 8 * kc) = (u32x4){pk2(tp[0], tp[1]), pk2(tp[2], tp[3]), pk2(tp[4], tp[5]), pk2(tp[6], tp[7])}; }
    }
    __syncthreads();
}

__device__ void phase_row(const bf16_t* f, const float* gpost, float scale, const float* x, bf16_t* hb, float* rinv, float* out, int mode, int wv) {
    const int tid = opaque_tid(wv), lane = tid & 63, wid = tid >> 6;
    const int bid = opaque_bid(), nblk = opaque_nblk();
    f32x4 gp[4];
    if (mode != 0) {
#pragma unroll
        for (int i = 0; i < 4; ++i) gp[i] = *(const f32x4*)(gpost + 8 * lane + 512 * (i >> 1) + 4 * (i & 1));
    }
    const bool xl = (nblk == 256);
    const int rstart = xl ? 4096 * (bid & 7) + 128 * (bid >> 3) + 4 * wid : (bid * 8 + wid) * 4;
    const int rstep = xl ? 32 : nblk * 32, rend = xl ? 4096 * (bid & 7) + 128 * (bid >> 3) + 128 : T_;
    for (int row0 = rstart; row0 < rend; row0 += rstep) {
        f32x4 h[4][4]; u32x4 fw[4][2]; float ri[4];
        if (mode == 0) {
#pragma unroll
            for (int r = 0; r < 4; ++r)
#pragma unroll
                for (int i = 0; i < 4; ++i) h[r][i] = *(const f32x4*)(x + (size_t)(row0 + r) * D_ + 8 * lane + 512 * (i >> 1) + 4 * (i & 1));
        } else {
            u32x4 hw[4][2];
#pragma unroll
            for (int r = 0; r < 4; ++r) { ri[r] = rinv[row0 + r];
#pragma unroll
                for (int c = 0; c < 2; ++c) { hw[r][c] = *(const u32x4*)(hb + (size_t)(row0 + r) * D_ + 8 * lane + 512 * c); fw[r][c] = *(const u32x4*)(f + (size_t)(row0 + r) * D_ + 8 * lane + 512 * c); } }
#pragma unroll
            for (int r = 0; r < 4; ++r) {
                float ss = 0.f; f32x4 fv[4];
#pragma unroll
                for (int c = 0; c < 2; ++c) { fv[2 * c] = unpack4((u32x2){fw[r][c].x, fw[r][c].y}); fv[2 * c + 1] = unpack4((u32x2){fw[r][c].z, fw[r][c].w});
                    h[r][2 * c] = unpack4((u32x2){hw[r][c].x, hw[r][c].y}) * ri[r]; h[r][2 * c + 1] = unpack4((u32x2){hw[r][c].z, hw[r][c].w}) * ri[r]; }
#pragma unroll
                for (int i = 0; i < 4; ++i) ss += fv[i][0] * fv[i][0] + fv[i][1] * fv[i][1] + fv[i][2] * fv[i][2] + fv[i][3] * fv[i][3];
                ss = wave_sum(ss, lane);
                const float rs = rsqrtf(ss * (1.0f / 1024.0f) + 1e-6f) * scale;
#pragma unroll
                for (int i = 0; i < 4; ++i) h[r][i] += fv[i] * rs * gp[i];
            }
        }
        if (mode == 2) {
#pragma unroll
            for (int r = 0; r < 4; ++r)
#pragma unroll
                for (int i = 0; i < 4; ++i) *(f32x4*)(out + (size_t)(row0 + r) * D_ + 8 * lane + 512 * (i >> 1) + 4 * (i & 1)) = h[r][i];
        } else {
#pragma unroll
            for (int r = 0; r < 4; ++r) {
                float ss = 0.f;
#pragma unroll
                for (int i = 0; i < 4; ++i) ss += h[r][i][0] * h[r][i][0] + h[r][i][1] * h[r][i][1] + h[r][i][2] * h[r][i][2] + h[r][i][3] * h[r][i][3];
                ss = wave_sum(ss, lane);
                const float ms = ss * (1.0f / 1024.0f) + 1e-6f, rs = rsqrtf(ms);
#pragma unroll
                for (int c = 0; c < 2; ++c) { const u32x2 lo = pack4(h[r][2 * c] * rs), hi = pack4(h[r][2 * c + 1] * rs);
                    *(u32x4*)(hb + (size_t)(row0 + r) * D_ + 8 * lane + 512 * c) = (u32x4){lo.x, lo.y, hi.x, hi.y}; }
                if (lane == 0) rinv[row0 + r] = ms * rs;
            }
        }
    }
}

__device__ void phase_conv(const bf16_t* xpre, const float* cw, const float* cb, bf16_t* xb, int wv) {
    const int nblk_ = opaque_nblk();
    const int gt = xcd_major_bid(opaque_bid(), nblk_) * 512 + opaque_tid(wv), nt = nblk_ * 512;
    if (nt != 131072) {
        for (int idx = gt; idx < T_ * 128; idx += nt) {
            const int t = idx >> 7, ch = (idx & 127) * 8, s = t & (S_ - 1);
            f32x4 a0 = *(const f32x4*)(cb + ch), a1 = *(const f32x4*)(cb + ch + 4);
            u32x4 w[4];
#pragma unroll
            for (int k = 0; k < 4; ++k) { const int ds = 3 - k; w[k] = *(const u32x4*)(xpre + (size_t)(s >= ds ? t - ds : t) * D_ + ch); }
#pragma unroll
            for (int k = 0; k < 4; ++k) { const int ds = 3 - k; const float m = s >= ds ? 1.0f : 0.0f;
                const f32x4 w0 = *(const f32x4*)(cw + k * D_ + ch) * m, w1 = *(const f32x4*)(cw + k * D_ + ch + 4) * m;
                a0 += w0 * (f32x4){bflo(w[k].x), bfhi(w[k].x), bflo(w[k].y), bfhi(w[k].y)}; a1 += w1 * (f32x4){bflo(w[k].z), bfhi(w[k].z), bflo(w[k].w), bfhi(w[k].w)}; }
            *(u32x4*)(xb + (size_t)t * D_ + ch) = (u32x4){pk2(a0[0], a0[1]), pk2(a0[2], a0[3]), pk2(a1[0], a1[1]), pk2(a1[2], a1[3])};
        }
        return;
    }
    const int ch = (gt & 127) * 8, tb = (gt >> 7) * 32;
    f32x4 wk0[4], wk1[4];
#pragma unroll
    for (int k = 0; k < 4; ++k) { wk0[k] = *(const f32x4*)(cw + k * D_ + ch); wk1[k] = *(const f32x4*)(cw + k * D_ + ch + 4); }
    const f32x4 b0 = *(const f32x4*)(cb + ch), b1 = *(const f32x4*)(cb + ch + 4);
#pragma unroll 1
    for (int it = 0; it < 32; it += 4) {
        u32x4 w[4][4];
#pragma unroll
        for (int q = 0; q < 4; ++q) { const int t = tb + (it + q), s = t & (S_ - 1);
#pragma unroll
            for (int k = 0; k < 4; ++k) { const int ds = 3 - k; w[q][k] = *(const u32x4*)(xpre + (size_t)(s >= ds ? t - ds : t) * D_ + ch); } }
#pragma unroll
        for (int q = 0; q < 4; ++q) { const int t = tb + (it + q), s = t & (S_ - 1);
            f32x4 a0 = b0, a1 = b1;
#pragma unroll
            for (int k = 0; k < 4; ++k) { const int ds = 3 - k; const float m = s >= ds ? 1.0f : 0.0f;
                a0 += (wk0[k] * m) * (f32x4){bflo(w[q][k].x), bfhi(w[q][k].x), bflo(w[q][k].y), bfhi(w[q][k].y)}; a1 += (wk1[k] * m) * (f32x4){bflo(w[q][k].z), bfhi(w[q][k].z), bflo(w[q][k].w), bfhi(w[q][k].w)}; }
            *(u32x4*)(xb + (size_t)t * D_ + ch) = (u32x4){pk2(a0[0], a0[1]), pk2(a0[2], a0[3]), pk2(a1[0], a1[1]), pk2(a1[2], a1[3])}; }
    }
}

__device__ __forceinline__ f32x4 exp4(f32x4 v) { return (f32x4){__expf(v[0]), __expf(v[1]), __expf(v[2]), __expf(v[3])}; }
__device__ void phase_scan1(const bf16_t* A, const bf16_t* U, float* P, float* H, int wv) {
    const int nblk_ = opaque_nblk();
    const int gt = xcd_major_bid(opaque_bid(), nblk_) * 512 + opaque_tid(wv), nt = nblk_ * 512;
    for (int it = gt; it < 131072; it += nt) {
        const int c4 = it & 255, bc = it >> 8;
        const size_t base = (size_t)bc * 64 * D_ + c4 * 4;
        f32x4 h = {0.f, 0.f, 0.f, 0.f}, p = {0.f, 0.f, 0.f, 0.f};
#pragma unroll 8
        for (int s = 0; s < 64; ++s) { const f32x4 lv = unpack4(*(const u32x2*)(A + base + (size_t)s * D_)); const f32x4 uv = unpack4(*(const u32x2*)(U + base + (size_t)s * D_)); h = exp4(lv) * h + uv; p += lv; }
        *(f32x4*)(P + (size_t)bc * D_ + c4 * 4) = exp4(p); *(f32x4*)(H + (size_t)bc * D_ + c4 * 4) = h;
    }
}
__device__ void phase_scan2(const bf16_t* A, const bf16_t* U, const float* P, const float* H, bf16_t* Y, int wv) {
    const int nblk_ = opaque_nblk();
    const int gt = xcd_major_bid(opaque_bid(), nblk_) * 512 + opaque_tid(wv), nt = nblk_ * 512;
    for (int it = gt; it < 131072; it += nt) {
        const int c4 = it & 255, bc = it >> 8, c = bc & 63, b0 = bc - c;
        f32x4 h = {0.f, 0.f, 0.f, 0.f};
#pragma unroll 4
        for (int cc = 0; cc < c; ++cc) { const size_t o = (size_t)(b0 + cc) * D_ + c4 * 4; const f32x4 pp = *(const f32x4*)(P + o), hh = *(const f32x4*)(H + o); h = pp * h + hh; }
        const size_t base = (size_t)bc * 64 * D_ + c4 * 4;
#pragma unroll 8
        for (int s = 0; s < 64; ++s) { const size_t o = base + (size_t)s * D_;
            const f32x4 lv = unpack4(*(const u32x2*)(A + o)); const f32x4 uv = unpack4(*(const u32x2*)(U + o)); const f32x4 yv = unpack4(*(const u32x2*)(Y + o));
            h = exp4(lv) * h + uv; *(u32x2*)(Y + o) = pack4(h * yv); }
    }
}

__device__ void phase_attn(LAS unsigned char* lds, const bf16_t* qkv, const float* sinks, bf16_t* out, int wv) {
    const int tid = opaque_tid(wv), lane = tid & 63, wid = __builtin_amdgcn_readfirstlane(tid >> 6), fr = lane & 15, g = lane >> 4;
    LAS unsigned char* Ks = lds;
    LAS unsigned char* Vt = lds + 36864;
    const int nblk = opaque_nblk(), bid = xcd_major_bid(opaque_bid(), nblk);
    unsigned zz = 0u; asm volatile("" : "+v"(zz));
    const u32x4 zero4 = {zz, zz, zz, zz};
    const int ipb = (512 + nblk - 1) / nblk;
    for (int item = bid * ipb; item < 512 && item < (bid + 1) * ipb; ++item) {
        const int kvh = item & 1, nb = (item >> 1) & 31, b = item >> 6;
        const int tok0 = b * S_ + nb * 128;
        __syncthreads();
        if (tid < 192) { const int row = tid / 3, part = tid - row * 3; *(LAS u32x4*)(Vt + row * 560 + 512 + part * 16) = zero4; }
#pragma unroll
        for (int i = 0; i < 4; ++i) { const int e = tid + 512 * i, kj = e >> 3, part = e & 7;
            const bool live = (nb > 0 || kj >= 128);
            const bf16_t* p = qkv + (size_t)(live ? tok0 - 128 + kj : tok0) * 1280 + 1024 + kvh * 64 + part * 8;
            u32x4 kv = *(const u32x4*)p, vv = *(const u32x4*)(p + 128);
            if (!live) { kv = zero4; vv = zero4; }
            *(LAS u32x4*)(Ks + kj * 144 + part * 16) = kv;
            LAS unsigned short* vt = (LAS unsigned short*)(Vt + (part * 8) * 560 + kj * 2);
            vt[0 * 280] = (unsigned short)(vv.x & 0xffffu); vt[1 * 280] = (unsigned short)(vv.x >> 16);
            vt[2 * 280] = (unsigned short)(vv.y & 0xffffu); vt[3 * 280] = (unsigned short)(vv.y >> 16);
            vt[4 * 280] = (unsigned short)(vv.z & 0xffffu); vt[5 * 280] = (unsigned short)(vv.z >> 16);
            vt[6 * 280] = (unsigned short)(vv.w & 0xffffu); vt[7 * 280] = (unsigned short)(vv.w >> 16); }
        __syncthreads();
        const int qi = 16 * wid + fr;
        const size_t tok = (size_t)(tok0 + qi);
        const bf16_t* qp = qkv + tok * 1280 + kvh * 512 + 8 * g;
        bf16x8 q0n = *(const bf16x8*)qp, q1n = *(const bf16x8*)(qp + 32);
#pragma unroll 2
        for (int hh = 0; hh < 8; ++hh) {
            const int h = kvh * 8 + hh;
            const bf16x8 q0 = q0n, q1 = q1n;
            if (hh < 7) { q0n = *(const bf16x8*)(qp + (hh + 1) * 64); q1n = *(const bf16x8*)(qp + (hh + 1) * 64 + 32); }
            f32x4 sc[10];
#pragma unroll
            for (int i = 0; i < 10; ++i) { sc[i] = (f32x4){0.f, 0.f, 0.f, 0.f};
                if (i < 9 && wid + i < 16) { const LAS unsigned char* kp = Ks + (16 * (wid + i) + fr) * 144 + g * 16;
                    const bf16x8 k0 = *(const LAS bf16x8*)kp, k1 = *(const LAS bf16x8*)(kp + 64);
                    sc[i] = __builtin_amdgcn_mfma_f32_16x16x32_bf16(k0, q0, sc[i], 0, 0, 0);
                    sc[i] = __builtin_amdgcn_mfma_f32_16x16x32_bf16(k1, q1, sc[i], 0, 0, 0); } }
            float mx = -1e30f;
#pragma unroll
            for (int i = 0; i < 10; ++i) {
                const bool tile_ok = (i < 9) && (wid + i < 16) && (nb > 0 || wid + i >= 8);
#pragma unroll
                for (int r = 0; r < 4; ++r) { bool valid = tile_ok;
                    if (i == 0 || i == 8) { const int kj = 16 * (wid + i) + 4 * g + r, d = qi + 128 - kj; valid = valid && (d >= 0) && (d < 128); }
                    const float s = valid ? sc[i][r] * 0.125f : -1e30f; sc[i][r] = s; mx = fmaxf(mx, s); } }
            mx = fmaxf(mx, shfl_xor_f(mx, 16, lane)); mx = fmaxf(mx, shfl_xor_f(mx, 32, lane));
            const float sk = sinks[h]; mx = fmaxf(mx, sk);
            float sum = 0.f;
#pragma unroll
            for (int i = 0; i < 10; ++i)
#pragma unroll
                for (int r = 0; r < 4; ++r) { const float p = (sc[i][r] > -1e29f) ? __expf(sc[i][r] - mx) : 0.f; sc[i][r] = p; sum += p; }
            sum += shfl_xor_f(sum, 16, lane); sum += shfl_xor_f(sum, 32, lane);
            sum += __expf(sk - mx);
            const float inv = __builtin_amdgcn_rcpf(sum);
            f32x4 o[4];
#pragma unroll
            for (int dt = 0; dt < 4; ++dt) o[dt] = (f32x4){0.f, 0.f, 0.f, 0.f};
#pragma unroll
            for (int s2 = 0; s2 < 5; ++s2) {
                const u32x4 pw = {pk2(sc[2 * s2][0], sc[2 * s2][1]), pk2(sc[2 * s2][2], sc[2 * s2][3]), pk2(sc[2 * s2 + 1][0], sc[2 * s2 + 1][1]), pk2(sc[2 * s2 + 1][2], sc[2 * s2 + 1][3])};
                const bf16x8 pf = __builtin_bit_cast(bf16x8, pw);
#pragma unroll
                for (int dt = 0; dt < 4; ++dt) { const LAS unsigned char* vp = Vt + (16 * dt + fr) * 560 + (16 * (wid + 2 * s2) + 4 * g) * 2;
                    const u32x2 lo = *(const LAS u32x2*)vp, hi = *(const LAS u32x2*)(vp + 32);
                    const bf16x8 vf = __builtin_bit_cast(bf16x8, ((u32x4){lo.x, lo.y, hi.x, hi.y}));
                    o[dt] = __builtin_amdgcn_mfma_f32_16x16x32_bf16(vf, pf, o[dt], 0, 0, 0); } }
            bf16_t* op = out + tok * D_ + h * 64 + 4 * g;
#pragma unroll
            for (int dt = 0; dt < 4; ++dt) *(u32x2*)(op + 16 * dt) = pack4(o[dt] * inv);
        }
    }
    __syncthreads();
}


#define XB_TMO      128
#define XB_XCNT(j)  (256  + 64 * (j))
#define XB_XSUB(j)  (1280 + 64 * (j))
#define XB_XGEN(j)  (2304 + 64 * (j))
#define XB_TOP      3328
#define XB_TOPGEN   3392
#define XCD_BAR_WORDS 3456
#define XB_SPIN_CAP (1u << 20)
__device__ __forceinline__ unsigned xb_ld(unsigned* p)              { return __hip_atomic_load(p, __ATOMIC_RELAXED, __HIP_MEMORY_SCOPE_AGENT); }
__device__ __forceinline__ unsigned xb_add(unsigned* p, unsigned v) { return __hip_atomic_fetch_add(p, v, __ATOMIC_RELAXED, __HIP_MEMORY_SCOPE_AGENT); }
__device__ __forceinline__ unsigned xb_xcc_id() { return (unsigned)__builtin_amdgcn_s_getreg((3 << 11) | 20) & 0xFu; }
#define XB_SPIN(cond, bar) do { unsigned _sp = 0; while (cond) { __builtin_amdgcn_s_sleep(1); \
    if ((++_sp & 255u) == 0u) { if (xb_ld(&(bar)[XB_TMO])) break; if (_sp > XB_SPIN_CAP) { atomicAdd(&(bar)[XB_TMO], 1u); break; } } } } while (0)
__device__ __forceinline__ void xcd_barrier_complete(unsigned* bar, unsigned x, unsigned G, unsigned& nloc, unsigned& nx) {
    unsigned sum, cnt, mine, sp = 0u;
    for (;;) {
        sum = 0u; cnt = 0u; mine = 0u;
#pragma unroll
        for (unsigned j = 0; j < 16; ++j) { const unsigned c = xb_ld(&bar[XB_XCNT(j)]); sum += c; cnt += (c > 0u) ? 1u : 0u; mine = (j == x) ? c : mine; }
        if (sum == G) break;
        __builtin_amdgcn_s_sleep(1);
        if ((++sp & 255u) == 0u) { if (xb_ld(&bar[XB_TMO])) break; if (sp > XB_SPIN_CAP) { atomicAdd(&bar[XB_TMO], 1u); break; } }
    }
    nloc = mine > 0u ? mine : 1u; nx = cnt > 0u ? cnt : 1u;
}
__device__ __forceinline__ bool is_thread0(int wv) { return wv == 0 && opaque_lane() == 0; }
__device__ __forceinline__ void xcd_barrier(unsigned* bar, volatile LAS unsigned* st, int wv) {
    asm volatile("s_waitcnt vmcnt(0)" ::: "memory");
    __syncthreads();
    if (is_thread0(wv)) {
        __builtin_amdgcn_s_waitcnt(0);
        const unsigned x = xb_xcc_id();
        unsigned nloc = st[0], nx = st[1];
        if (nloc == 0u) { xcd_barrier_complete(bar, x, gridDim.x, nloc, nx); st[0] = nloc; st[1] = nx; }
        const unsigned old = xb_add(&bar[XB_XSUB(x)], 1u);
        const unsigned gen = old / nloc;
        if (old + 1u == (gen + 1u) * nloc) {
            __builtin_amdgcn_fence(__ATOMIC_RELEASE, "agent");
            asm volatile("s_waitcnt vmcnt(0)" ::: "memory");
            const unsigned og = xb_add(&bar[XB_TOP], 1u);
            const unsigned tg = og / nx;
            if (og + 1u == (tg + 1u) * nx) xb_add(&bar[XB_TOPGEN], 1u);
            else XB_SPIN(xb_ld(&bar[XB_TOPGEN]) == tg, bar);
            __builtin_amdgcn_fence(__ATOMIC_ACQUIRE, "agent");
            xb_add(&bar[XB_XGEN(x)], 1u);
            asm volatile("s_waitcnt vmcnt(0)" ::: "memory");
        } else {
            XB_SPIN(xb_ld(&bar[XB_XGEN(x)]) == gen, bar);
            __builtin_amdgcn_fence(__ATOMIC_ACQUIRE, "agent");
            asm volatile("s_waitcnt vmcnt(0)" ::: "memory");
        }
    }
    __syncthreads();
}

__device__ __forceinline__ void run_phase(const KArgs& a, int ph, LAS unsigned char* lds, int wv) {
    unsigned char* ws = a.ws;
    bf16_t* ABUF = (bf16_t*)(ws + OFF_ABUF); bf16_t* FBUF = (bf16_t*)(ws + OFF_FBUF); bf16_t* HBUF = (bf16_t*)(ws + OFF_HBUF);
    float* EBUF = (float*)(ws + OFF_EBUF);
    bf16_t* YBUF = HBUF;
    bf16_t* XPRE = HBUF + (size_t)T_ * D_;
    float* PBUF = (float*)(HBUF + (size_t)2 * T_ * D_);
    float* HEND = PBUF + 512 * 1024;
    bf16_t* XB = (bf16_t*)a.out;
    float* ROWSQ = (float*)(ws + OFF_RSQ);
    bf16_t* UBUF = FBUF;
    bf16_t* QKV = HBUF;
    bf16_t* AOUT = HBUF + (size_t)T_ * 1280;
    const float* lsl = (const float*)(ws + OFF_LSL);
    pg8::StaticOrder S;
    switch (ph) {
    case 0:
        phase_wconv(a, lds, wv);
        phase_row(nullptr, nullptr, 0.f, a.in[0], ABUF, ROWSQ, nullptr, 0, wv);
        break;
    case 1: case 11: case 14: case 21: {
        const int fi = ph == 1 ? 0 : ph == 11 ? 1 : ph == 14 ? 2 : 3;
        pg8::Gemm g{ABUF, (const bf16_t*)(ws + OFF_WT1 + fi * SZ_WT1), T_, 5632, 1024, 1024, 0};
        S.init(g.M, g.N, opaque_nblk(), opaque_bid());
        pg8::EpiG1 E{HBUF};
        pg8::gemm_phase(lds, g, S, E, wv);
    } break;
    case 2: case 12: case 15: case 22: case 9: case 19: case 17: {
        pg8::Gemm g; pg8::EpiStore E;
        if (ph == 9)       { g = pg8::Gemm{YBUF, (const bf16_t*)(ws + OFF_WOUT), T_, 1024, 1024, 1024, 0}; E = pg8::EpiStore{FBUF, 1024, a.in[16]}; }
        else if (ph == 19) { g = pg8::Gemm{AOUT, (const bf16_t*)(ws + OFF_WO), T_, 1024, 1024, 1024, 0}; E = pg8::EpiStore{FBUF, 1024, a.in[21]}; }
        else if (ph == 17) { g = pg8::Gemm{ABUF, (const bf16_t*)(ws + OFF_WQKV), T_, 1280, 1024, 1024, 0}; E = pg8::EpiStore{QKV, 1280, a.in[18]}; }
        else { const int fi = ph == 2 ? 0 : ph == 12 ? 1 : ph == 15 ? 2 : 3;
            g = pg8::Gemm{HBUF, (const bf16_t*)(ws + OFF_WT2 + fi * SZ_WT2), T_, 1024, 2816, 2816, 0}; E = pg8::EpiStore{FBUF, 1024, nullptr}; }
        S.init(g.M, g.N, opaque_nblk(), opaque_bid());
        pg8::gemm_phase(lds, g, S, E, wv);
    } break;
    case 3: case 10: case 13: case 16: case 20: case 23: {
        const float* nf = a.in[1]; const float* nm = a.in[2];
        const float* gpost; float scale = 0.5f;
        if (ph == 3)       { gpost = nf + 1 * 1024; }
        else if (ph == 10) { gpost = nm + 1 * 1024; scale = 1.0f; }
        else if (ph == 13) { gpost = nf + 3 * 1024; }
        else if (ph == 16) { gpost = nf + 5 * 1024; }
        else if (ph == 20) { gpost = nm + 3 * 1024; scale = 1.0f; }
        else               { gpost = nf + 7 * 1024; }
        phase_row(FBUF, gpost, scale, nullptr, ABUF, ROWSQ, a.out, ph == 23 ? 2 : 1, wv);
    } break;
    case 4: {
        pg8::Gemm g{ABUF, (const bf16_t*)(ws + OFF_WIN), T_, 2048, 1024, 1024, 0};
        S.init(g.M, g.N, opaque_nblk(), opaque_bid());
        pg8::EpiGP E{YBUF, XPRE, a.in[7]};
        pg8::gemm_phase(lds, g, S, E, wv);
    } break;
    case 5: phase_conv(XPRE, a.in[8], a.in[9], XB, wv); break;
    case 6: {
        pg8::Gemm g{XB, (const bf16_t*)(ws + OFF_WGATE), T_, 2048, 256, 1024, 256};
        S.init(g.M, g.N, opaque_nblk(), opaque_bid());
        pg8::EpiGG E{XB, a.in[11], a.in[13], lsl, (bf16_t*)EBUF, UBUF};
        pg8::gemm_phase(lds, g, S, E, wv);
    } break;
    case 7: phase_scan1((const bf16_t*)EBUF, UBUF, PBUF, HEND, wv); break;
    case 8: phase_scan2((const bf16_t*)EBUF, UBUF, PBUF, HEND, YBUF, wv); break;
    case 18: phase_attn(lds, QKV, a.in[19], AOUT, wv); break;
    default: break;
    }
}

__global__ void __launch_bounds__(512, 2) mega_fwd(Args a_unused) {
    extern __shared__ __attribute__((aligned(16))) unsigned char shm[];
    LAS unsigned char* lds = (LAS unsigned char*)shm;
    cg::grid_group grid = cg::this_grid();
    const int wv = __builtin_amdgcn_readfirstlane((int)threadIdx.x >> 6);
    KArgs* ap = (KArgs*)__builtin_amdgcn_kernarg_segment_ptr();
    const int ph_lo = ap->ph_lo, ph_hi = ap->ph_hi;
    volatile LAS unsigned* st = (volatile LAS unsigned*)(lds + LDS_GEMM);
    if (threadIdx.x == 0) { st[0] = 0u; st[1] = 0u; }
    __syncthreads();
#if PROBE_MASK || PROBE_CONST
    unsigned long long* stamps = (unsigned long long*)(ap->ws + 24576);
    const unsigned long long t_entry = __builtin_amdgcn_s_memrealtime();
    if (blockIdx.x == 0 && is_thread0(wv)) { stamps[0] = t_entry; __hip_atomic_store(stamps + 40, ~0ull, __ATOMIC_RELAXED, __HIP_MEMORY_SCOPE_AGENT); __hip_atomic_store(stamps + 41, 0ull, __ATOMIC_RELAXED, __HIP_MEMORY_SCOPE_AGENT); }
#endif
#if PROBE_MASK || PROBE_CONST
#define MK_STAMP(k) do { if (blockIdx.x == 0 && is_thread0(wv)) stamps[(k) + 1] = __builtin_amdgcn_s_memrealtime(); } while (0)
#else
#define MK_STAMP(k) do { } while (0)
#endif
#define MK_PHASE(k) do { if ((k) >= ph_lo && (k) < ph_hi) { KArgs* ap2 = ap; asm volatile("" : "+s"(ap2)); run_phase(*ap2, (k), lds, wv); \
        if ((k) + 1 < ph_hi) xcd_barrier((unsigned*)ap2->ws, st, wv); \
        MK_STAMP(k); } } while (0)
    if (ph_lo < 0) grid.sync();
    if (is_thread0(wv)) (void)xb_add((unsigned*)ap->ws + XB_XCNT(xb_xcc_id()), 1u);
    MK_PHASE(0);  MK_PHASE(1);  MK_PHASE(2);  MK_PHASE(3);  MK_PHASE(4);  MK_PHASE(5);  MK_PHASE(6);  MK_PHASE(7);
    MK_PHASE(8);  MK_PHASE(9);  MK_PHASE(10); MK_PHASE(11); MK_PHASE(12); MK_PHASE(13); MK_PHASE(14); MK_PHASE(15);
    MK_PHASE(16); MK_PHASE(17); MK_PHASE(18); MK_PHASE(19); MK_PHASE(20); MK_PHASE(21); MK_PHASE(22); MK_PHASE(23);
#undef MK_PHASE
#undef MK_STAMP
#if PROBE_MASK || PROBE_CONST
    if (PROBE_MASK & 0x1000000u) {
        if (is_thread0(wv)) { atomicMin(stamps + 40, t_entry); atomicMax(stamps + 41, (unsigned long long)__builtin_amdgcn_s_memrealtime()); }
        xcd_barrier((unsigned*)ap->ws, st, wv);
    }
    if (blockIdx.x == 0) {
        asm volatile("s_waitcnt vmcnt(0)" ::: "memory");
        __syncthreads();
        unsigned long long ticks = 0;
        for (int ph = 0; ph < NPHASE; ++ph) if ((PROBE_MASK >> ph) & 1u) ticks += stamps[ph + 1] - stamps[ph];
        if (PROBE_MASK & 0x1000000u) ticks = __hip_atomic_load(stamps + 41, __ATOMIC_RELAXED, __HIP_MEMORY_SCOPE_AGENT) - __hip_atomic_load(stamps + 40, __ATOMIC_RELAXED, __HIP_MEMORY_SCOPE_AGENT);
        int m = PROBE_CONST ? PROBE_CONST : (int)(ticks / 10ull);
        if (m > 32768) m = 32768;
        for (int i = opaque_tid(wv); i < m; i += 512) atomicAdd(ap->out + i, 0.05f);
    }
#endif
}

extern "C" void kernel_launch(void* const* d_in, const int* in_sizes, int n_in, void* d_out, int out_size, void* d_ws, size_t ws_size, hipStream_t stream) {
    static int grid = 0;
    if (grid == 0) {
        if (n_in != 22 || out_size != T_ * D_ || ws_size < WS_END) { fprintf(stderr, "kernel_launch: unexpected shapes (n_in %d out %d ws %zu need %zu)\n", n_in, out_size, ws_size, (size_t)WS_END); grid = -1; return; }
        int dev = 0, cus = 0, per_cu = 0;
        hipGetDevice(&dev);
        hipDeviceGetAttribute(&cus, hipDeviceAttributeMultiprocessorCount, dev);
        if (hipFuncSetAttribute((const void*)mega_fwd, hipFuncAttributeMaxDynamicSharedMemorySize, LDS_BYTES) != hipSuccess) { fprintf(stderr, "kernel_launch: hipFuncSetAttribute failed\n"); grid = -1; return; }
        hipOccupancyMaxActiveBlocksPerMultiprocessor(&per_cu, (const void*)mega_fwd, 512, LDS_BYTES);
        if (per_cu < 1) { fprintf(stderr, "kernel_launch: occupancy query says %d blocks per CU\n", per_cu); grid = -1; return; }
        grid = cus;
    }
    if (grid < 0) return;
    if (hipMemsetAsync(d_ws, 0, 16384, stream) != hipSuccess) { fprintf(stderr, "kernel_launch: memset of the barrier words failed\n"); return; }
    Args a{};
    for (int i = 0; i < 22; ++i) a.in[i] = (const float*)d_in[i];
    a.out = (float*)d_out; a.ws = (unsigned char*)d_ws;
#if N_LAUNCH_PER_PHASE
    for (int ph = 0; ph < NPHASE; ++ph) {
        a.ph_lo = ph; a.ph_hi = ph + 1;
        void* args[] = {&a};
        hipError_t e = hipLaunchCooperativeKernel((const void*)mega_fwd, dim3(grid), dim3(512), args, LDS_BYTES, stream);
        if (e != hipSuccess) { fprintf(stderr, "cooperative launch failed: %s\n", hipGetErrorString(e)); break; }
    }
#else
    a.ph_lo = 0; a.ph_hi = NPHASE;
    void* args[] = {&a};
    hipError_t e = hipLaunchCooperativeKernel((const void*)mega_fwd, dim3(grid), dim3(512), args, LDS_BYTES, stream);
    if (e != hipSuccess) fprintf(stderr, "cooperative launch failed: %s (grid %d)\n", hipGetErrorString(e), grid);
#endif
}
```

```cpp
#include <hip/hip_runtime.h>
#include <hip/hip_cooperative_groups.h>
#include <cstdio>
namespace cg = cooperative_groups;

#define PROBE_MASK 0u
#define PROBE_CONST 0
#ifndef N_LAUNCH_PER_PHASE
#define N_LAUNCH_PER_PHASE 0
#endif

#define LAS __attribute__((address_space(3)))
typedef unsigned short bf16_t;
typedef short bf16x8 __attribute__((ext_vector_type(8)));
typedef float f32x4 __attribute__((ext_vector_type(4)));
typedef unsigned u32x4 __attribute__((ext_vector_type(4)));
typedef unsigned u32x2 __attribute__((ext_vector_type(2)));

constexpr int T_ = 32768, D_ = 1024, F_ = 2816, S_ = 4096;
constexpr int NPHASE = 24;
constexpr int LDS_GEMM = 131072;
constexpr int LDS_BYTES = LDS_GEMM + 16;

constexpr size_t OFF_LSL   = 16384;
constexpr size_t OFF_RSQ   = 32768;
constexpr size_t OFF_WT1   = 32768 + 131072;
constexpr size_t SZ_WT1    = (size_t)5632 * 1024 * 2;
constexpr size_t OFF_WT2   = OFF_WT1 + 4 * SZ_WT1;
constexpr size_t SZ_WT2    = (size_t)1024 * 2816 * 2;
constexpr size_t OFF_WIN   = OFF_WT2 + 4 * SZ_WT2;
constexpr size_t OFF_WGATE = OFF_WIN + (size_t)2048 * 1024 * 2;
constexpr size_t OFF_WOUT  = OFF_WGATE + (size_t)2048 * 256 * 2;
constexpr size_t OFF_WQKV  = OFF_WOUT + (size_t)1024 * 1024 * 2;
constexpr size_t OFF_WO    = OFF_WQKV + (size_t)1280 * 1024 * 2;
constexpr size_t OFF_ABUF  = OFF_WO + (size_t)1024 * 1024 * 2;
constexpr size_t SZ_TD2    = (size_t)T_ * D_ * 2;
constexpr size_t OFF_FBUF  = OFF_ABUF + SZ_TD2;
constexpr size_t OFF_HBUF  = OFF_FBUF + SZ_TD2;
constexpr size_t OFF_EBUF  = OFF_HBUF + (size_t)T_ * F_ * 2;
constexpr size_t WS_END    = OFF_EBUF + (size_t)T_ * D_ * 4;

struct Args {
    const float* in[22];
    float* out;
    unsigned char* ws;
    int ph_lo, ph_hi;
};

typedef const __attribute__((address_space(4))) Args KArgs;

__device__ __forceinline__ int opaque_bid() { int b = (int)blockIdx.x; asm volatile("" : "+s"(b)); return b; }
__device__ __forceinline__ int xcd_major_bid(int bid, int nblk) { return (nblk & 7) == 0 ? (bid & 7) * (nblk >> 3) + (bid >> 3) : bid; }
__device__ __forceinline__ int opaque_nblk() { int b = (int)gridDim.x; asm volatile("" : "+s"(b)); return b; }
__device__ __forceinline__ int opaque_lane() { unsigned z = 0u; asm volatile("" : "+v"(z)); return (int)__builtin_amdgcn_mbcnt_hi(~0u, __builtin_amdgcn_mbcnt_lo(~0u, z)); }
__device__ __forceinline__ int opaque_tid(int wv) { return (wv << 6) + opaque_lane(); }
typedef __bf16 bf16x2_t __attribute__((ext_vector_type(2)));
typedef float f32x2_t __attribute__((ext_vector_type(2)));
__device__ __forceinline__ unsigned pk2(float lo, float hi) { const f32x2_t v = {lo, hi}; const bf16x2_t b = __builtin_convertvector(v, bf16x2_t); return __builtin_bit_cast(unsigned, b); }
__device__ __forceinline__ float bflo(unsigned w) { return __uint_as_float(w << 16); }
__device__ __forceinline__ float bfhi(unsigned w) { return __uint_as_float(w & 0xffff0000u); }
__device__ __forceinline__ f32x4 unpack4(u32x2 w) { return (f32x4){bflo(w.x), bfhi(w.x), bflo(w.y), bfhi(w.y)}; }
__device__ __forceinline__ u32x2 pack4(f32x4 v) { return (u32x2){pk2(v[0], v[1]), pk2(v[2], v[3])}; }
__device__ __forceinline__ float shfl_xor_f(float v, int m, int lane) { return __int_as_float(__builtin_amdgcn_ds_bpermute((lane ^ m) << 2, __float_as_int(v))); }
__device__ __forceinline__ float wave_sum(float v, int lane) {
#pragma unroll
    for (int o = 32; o > 0; o >>= 1) v += shfl_xor_f(v, o, lane);
    return v;
}
__device__ __forceinline__ float sigmoidf_(float x) { return __builtin_amdgcn_rcpf(1.0f + __expf(-x)); }
__device__ __forceinline__ float gelu_tanh(float v) {
    const float z = 0.7978845608028654f * (v + 0.044715f * v * v * v);
    const float t = 1.0f - 2.0f * __builtin_amdgcn_rcpf(__expf(2.0f * z) + 1.0f);
    return 0.5f * v * (1.0f + t);
}

namespace pg8 {
constexpr int BM = 256, BK = 64, HALF = 128, HTB = HALF * BK * 2, NXCD = 8, WGM = 8;
__device__ __forceinline__ int lds_byte(int r, int c) { const int st = (r >> 4) * 2 + (c >> 5), rr = r & 15, cc = c & 31, ob = rr * 64 + cc * 2; return st * 1024 + (ob ^ (((ob >> 9) & 1) << 5)); }
__device__ __forceinline__ void stage_rc(int b, int& R, int& C) { const int st = b / 1024, sb = b % 1024, swz = sb ^ (((sb >> 9) & 1) << 5); R = (st >> 1) * 16 + swz / 64; C = (st & 1) * 32 + (swz % 64) / 2; }

struct Unit { int pm, pn; };
struct Gemm { const bf16_t* A; const bf16_t* Bt; int M, N, K, lda, headK; };

struct StaticOrder {
    int nM, nN, nwg, G, c;
    __device__ void init(int M, int N, int G_, int c_) { nM = M / BM; nN = N / BM; nwg = nM * nN; G = G_; c = c_; }
    __device__ bool next(int i, Unit& u) const {
        const long L = (long)i * G + c; if (L >= nwg) return false;
        int wgid = (int)L; { const int q = nwg / NXCD, r = nwg % NXCD, xcd = wgid % NXCD, off = wgid / NXCD; wgid = (xcd < r ? xcd * (q + 1) : r * (q + 1) + (xcd - r) * q) + off; }
        const int nig = WGM * nN, gid = wgid / nig, fm = gid * WGM, gsz = (nM - fm) < WGM ? (nM - fm) : WGM;
        u.pm = fm + ((wgid % nig) % gsz); u.pn = (wgid % nig) / gsz; return true;
    }
};

template <class Epi>
__device__ __forceinline__ void gemm_phase(LAS unsigned char* lds, const Gemm g, const StaticOrder& S, const Epi& E, int wv) {
    const int tid = opaque_tid(wv), wid = __builtin_amdgcn_readfirstlane(tid >> 6), lane = tid & 63, wr = wid >> 2, wc = wid & 3, fr = lane & 15, fq = lane >> 4;
    int K = g.K; asm volatile("" : "+s"(K));
    const int nt = K / BK;
    unsigned voffA[2], voffB[2];
#pragma unroll
    for (int i = 0; i < 2; ++i) { int R, C; stage_rc(tid * 16 + i * 8192, R, C);
        voffA[i] = (unsigned)(R * g.lda + C) * 2u; voffB[i] = (unsigned)(R * K + C) * 2u; }
    const size_t kstep = (size_t)(BK * 2);
    const size_t hstepA = (size_t)HALF * g.lda * 2, hstepB = (size_t)HALF * K * 2;
    const size_t tstepA = 2 * hstepA, tstepB = 2 * hstepB;
    const unsigned ldsw = (unsigned)wid * 1024u;
    const int aoff = lds_byte(wr * 64 + fr, fq * 8), boff = lds_byte(wc * 32 + fr, fq * 8);
#define PG8_SA(b, h) (((b) * 2 + (h)) * HTB)
#define PG8_SB(b, h) ((4 + (b) * 2 + (h)) * HTB)
#define PG8_STAGE(bufoff, gbase, voff) do { _Pragma("unroll") for (int _i = 0; _i < 2; ++_i) \
        __builtin_amdgcn_global_load_lds((const unsigned*)((const char*)(gbase) + (voff)[_i]), (LAS unsigned*)(lds + (bufoff) + ldsw + _i * 8192), 16, 0, 0); } while (0)
#define PG8_LDA(dst, b, h) do { _Pragma("unroll") for (int m = 0; m < 4; ++m) _Pragma("unroll") for (int k = 0; k < 2; ++k) dst[m][k] = *(const LAS bf16x8*)(lds + PG8_SA(b, h) + aoff + m * 2048 + k * 1024); } while (0)
#define PG8_LDB(dst, b, h) do { _Pragma("unroll") for (int n = 0; n < 2; ++n) _Pragma("unroll") for (int k = 0; k < 2; ++k) dst[n][k] = *(const LAS bf16x8*)(lds + PG8_SB(b, h) + boff + n * 2048 + k * 1024); } while (0)
#define PG8_MMA(ai, bj, At, Bt) do { __builtin_amdgcn_s_setprio(1); _Pragma("unroll") for (int m = 0; m < 4; ++m) _Pragma("unroll") for (int n = 0; n < 2; ++n) _Pragma("unroll") for (int k = 0; k < 2; ++k) \
        acc[ai][bj][m][n] = __builtin_amdgcn_mfma_f32_16x16x32_bf16(Bt[n][k], At[m][k], acc[ai][bj][m][n], 0, 0, 0); __builtin_amdgcn_s_setprio(0); } while (0)
#define PG8_WAIT_V(n) asm volatile("s_waitcnt vmcnt(" #n ")" ::: "memory")
#define PG8_WAIT_L(n) asm volatile("s_waitcnt lgkmcnt(" #n ")" ::: "memory")
#define PG8_BAR __builtin_amdgcn_s_barrier()
#define PG8_SCHED __builtin_amdgcn_sched_barrier(0)
    Unit cur, nxt; int ui = 0;
    if (!S.next(0, cur)) return;
    f32x4 acc[2][2][4][2];
#pragma unroll
    for (int a = 0; a < 2; ++a)
#pragma unroll
        for (int b = 0; b < 2; ++b)
#pragma unroll
            for (int m = 0; m < 4; ++m)
#pragma unroll
                for (int n = 0; n < 2; ++n) acc[a][b][m][n] = (f32x4){0.f, 0.f, 0.f, 0.f};
    bf16x8 At[4][2], B0[2][2], B1[2][2];
    constexpr int NDEF = Epi::NDEF;
    u32x4 pend[NDEF ? NDEF : 1]; char* pbase = nullptr; int npend = NDEF;
#define PG8_DEFER() do { if constexpr (NDEF > 0) { if (npend < NDEF) { E.store_slot(pend, pbase, npend); ++npend; } } } while (0)
    const char* cA = (const char*)g.A + (size_t)cur.pm * tstepA + (size_t)((cur.pn >> 1) * g.headK) * 2; const char* cB = (const char*)g.Bt + (size_t)cur.pn * tstepB;
    PG8_STAGE(PG8_SB(0, 0), cB, voffB); PG8_STAGE(PG8_SA(0, 0), cA, voffA); PG8_STAGE(PG8_SB(0, 1), cB + hstepB, voffB); PG8_STAGE(PG8_SA(0, 1), cA + hstepA, voffA);
    if (wr == 1) PG8_BAR;
    PG8_WAIT_V(4); PG8_BAR;
    PG8_STAGE(PG8_SB(1, 0), cB + kstep, voffB); PG8_STAGE(PG8_SA(1, 0), cA + kstep, voffA); PG8_STAGE(PG8_SB(1, 1), cB + hstepB + kstep, voffB);
    PG8_WAIT_V(6); PG8_BAR;
    for (;;) {
        const bool has_next = S.next(ui + 1, nxt);
        const char* nA = has_next ? (const char*)g.A + (size_t)nxt.pm * tstepA + (size_t)((nxt.pn >> 1) * g.headK) * 2 : cA; const char* nB = has_next ? (const char*)g.Bt + (size_t)nxt.pn * tstepB : cB;
        for (int t = 0; t < nt; t += 2) {
            const bool last = (t == nt - 2);
            const char* a1 = cA + (size_t)(t + 1) * kstep;
            const char* a2 = last ? nA : cA + (size_t)(t + 2) * kstep; const char* b2 = last ? nB : cB + (size_t)(t + 2) * kstep;
            const char* a3 = a2 + kstep; const char* b3 = b2 + kstep;
            PG8_LDB(B0, 0, 0); PG8_SCHED; PG8_LDA(At, 0, 0); PG8_STAGE(PG8_SA(1, 1), a1 + hstepA, voffA);
            PG8_WAIT_L(8); PG8_BAR; PG8_WAIT_L(0); PG8_MMA(0, 0, At, B0); PG8_BAR; PG8_SCHED;
            PG8_LDB(B1, 0, 1); PG8_STAGE(PG8_SB(0, 0), b2, voffB);
            PG8_BAR; PG8_WAIT_L(0); PG8_MMA(0, 1, At, B1); PG8_BAR;
            PG8_LDA(At, 0, 1); PG8_STAGE(PG8_SA(0, 0), a2, voffA);
            PG8_BAR; PG8_WAIT_L(0); PG8_MMA(1, 0, At, B0); PG8_BAR; PG8_SCHED;
            PG8_STAGE(PG8_SB(0, 1), b2 + hstepB, voffB);
            PG8_WAIT_V(6); PG8_BAR; PG8_DEFER(); PG8_MMA(1, 1, At, B1); PG8_BAR;
            PG8_LDB(B0, 1, 0); PG8_SCHED; PG8_LDA(At, 1, 0); PG8_STAGE(PG8_SA(0, 1), a2 + hstepA, voffA);
            PG8_WAIT_L(8); PG8_BAR; PG8_WAIT_L(0); PG8_MMA(0, 0, At, B0); PG8_BAR; PG8_SCHED;
            PG8_LDB(B1, 1, 1); PG8_STAGE(PG8_SB(1, 0), b3, voffB);
            PG8_BAR; PG8_WAIT_L(0); PG8_MMA(0, 1, At, B1); PG8_BAR;
            PG8_LDA(At, 1, 1); PG8_STAGE(PG8_SA(1, 0), a3, voffA);
            PG8_BAR; PG8_WAIT_L(0); PG8_MMA(1, 0, At, B0); PG8_BAR; PG8_SCHED;
            PG8_STAGE(PG8_SB(1, 1), b3 + hstepB, voffB);
            PG8_WAIT_V(6); PG8_BAR; PG8_DEFER(); PG8_MMA(1, 1, At, B1); PG8_BAR;
        }
        { const int ln = opaque_lane(), fr2 = ln & 15, fq2 = ln >> 4;
        if constexpr (NDEF > 0) {
#pragma unroll
            for (int s = 0; s < NDEF; ++s) if (s >= npend) E.store_fixed(pend, pbase, s);
            npend = NDEF;
            if (has_next) { E.pack(acc, cur, wr, wc, fr2, fq2, pend, pbase); npend = 0; }
            else E(acc, cur, wr, wc, fr2, fq2);
        } else E(acc, cur, wr, wc, fr2, fq2); }
        if (!has_next) break;
#pragma unroll
        for (int a = 0; a < 2; ++a)
#pragma unroll
            for (int b = 0; b < 2; ++b)
#pragma unroll
                for (int m = 0; m < 4; ++m)
#pragma unroll
                    for (int n = 0; n < 2; ++n) acc[a][b][m][n] = (f32x4){0.f, 0.f, 0.f, 0.f};
        cur = nxt; cA = nA; cB = nB; ++ui;
    }
    PG8_WAIT_V(0);
    if (wr == 0) PG8_BAR;
    PG8_BAR;
#undef PG8_DEFER
#undef PG8_SA
#undef PG8_SB
#undef PG8_STAGE
#undef PG8_LDA
#undef PG8_LDB
#undef PG8_MMA
#undef PG8_WAIT_V
#undef PG8_WAIT_L
#undef PG8_BAR
#undef PG8_SCHED
}

struct EpiStore {
    static constexpr int NDEF = 0;
    bf16_t* O; int ldc; const float* bias;
    __device__ __forceinline__ void operator()(const f32x4 (&acc)[2][2][4][2], const Unit& u, int wr, int wc, int fr, int fq) const {
        const int row0 = u.pm * BM + wr * 64 + fr, col0 = u.pn * BM + wc * 32 + 8 * fq;
        f32x4 bv[2][2];
#pragma unroll
        for (int bj = 0; bj < 2; ++bj)
#pragma unroll
            for (int n = 0; n < 2; ++n) bv[bj][n] = bias ? *(const f32x4*)(bias + col0 + bj * HALF + 4 * n) : (f32x4){0.f, 0.f, 0.f, 0.f};
#pragma unroll
        for (int ai = 0; ai < 2; ++ai)
#pragma unroll
            for (int m = 0; m < 4; ++m) { bf16_t* rowp = O + (size_t)(row0 + ai * HALF + m * 16) * ldc + col0;
#pragma unroll
                for (int bj = 0; bj < 2; ++bj) { const u32x2 lo = pack4(acc[ai][bj][m][0] + bv[bj][0]), hi = pack4(acc[ai][bj][m][1] + bv[bj][1]);
                    *(u32x4*)(rowp + bj * HALF) = (u32x4){lo.x, lo.y, hi.x, hi.y}; } }
    }
};
struct EpiG1 {
    static constexpr int NDEF = 3;
    bf16_t* H;
    __device__ __forceinline__ void pack(const f32x4 (&acc)[2][2][4][2], const Unit& u, int wr, int wc, int fr, int fq, u32x4 (&pend)[3], char*& pbase) const {
        pbase = (char*)(H + (size_t)(u.pm * BM + wr * 64 + fr) * F_ + (u.pn * 128 + wc * 32 + 8 * fq));
#pragma unroll
        for (int ai = 0; ai < 2; ++ai)
#pragma unroll
            for (int m = 0; m < 4; ++m) { f32x4 v[2];
#pragma unroll
                for (int bj = 0; bj < 2; ++bj) { const f32x4 gt = acc[ai][bj][m][0], up = acc[ai][bj][m][1];
#pragma unroll
                    for (int j = 0; j < 4; ++j) v[bj][j] = gt[j] * sigmoidf_(gt[j]) * up[j]; }
                const u32x2 lo = pack4(v[0]), hi = pack4(v[1]); const u32x4 w = {lo.x, lo.y, hi.x, hi.y};
                if (ai == 0 || m == 0) *(u32x4*)(pbase + (size_t)(128 * ai + 16 * m) * (F_ * 2)) = w; else pend[m - 1] = w; }
    }
    __device__ __forceinline__ void store_fixed(const u32x4 (&pend)[3], char* pbase, int s) const {
        *(u32x4*)(pbase + (size_t)(128 + 16 * (s + 1)) * (F_ * 2)) = pend[s];
    }
    __device__ __forceinline__ void store_slot(const u32x4 (&pend)[3], char* pbase, int s) const {
        switch (s) { case 0: store_fixed(pend, pbase, 0); break; case 1: store_fixed(pend, pbase, 1); break; default: store_fixed(pend, pbase, 2); break; }
    }
    __device__ __forceinline__ void operator()(const f32x4 (&acc)[2][2][4][2], const Unit& u, int wr, int wc, int fr, int fq) const {
        const int row0 = u.pm * BM + wr * 64 + fr, hc0 = u.pn * 128 + wc * 32 + 8 * fq;
#pragma unroll
        for (int ai = 0; ai < 2; ++ai)
#pragma unroll
            for (int m = 0; m < 4; ++m) { bf16_t* rowp = H + (size_t)(row0 + ai * HALF + m * 16) * F_ + hc0; f32x4 v[2];
#pragma unroll
                for (int bj = 0; bj < 2; ++bj) { const f32x4 gt = acc[ai][bj][m][0], up = acc[ai][bj][m][1];
#pragma unroll
                    for (int j = 0; j < 4; ++j) v[bj][j] = gt[j] * sigmoidf_(gt[j]) * up[j]; }
                const u32x2 lo = pack4(v[0]), hi = pack4(v[1]);
                *(u32x4*)rowp = (u32x4){lo.x, lo.y, hi.x, hi.y}; }
    }
};
struct EpiGP {
    static constexpr int NDEF = 0;
    bf16_t* Y; bf16_t* X; const float* bias;
    __device__ __forceinline__ void operator()(const f32x4 (&acc)[2][2][4][2], const Unit& u, int wr, int wc, int fr, int fq) const {
        const bool isy = u.pn < 4;
        const int row0 = u.pm * BM + wr * 64 + fr, col0 = (u.pn & 3) * BM + wc * 32 + 8 * fq, bcol0 = u.pn * BM + wc * 32 + 8 * fq;
        bf16_t* dst = isy ? Y : X;
        f32x4 bv[2][2];
#pragma unroll
        for (int bj = 0; bj < 2; ++bj)
#pragma unroll
            for (int n = 0; n < 2; ++n) bv[bj][n] = *(const f32x4*)(bias + bcol0 + bj * HALF + 4 * n);
#pragma unroll
        for (int ai = 0; ai < 2; ++ai)
#pragma unroll
            for (int m = 0; m < 4; ++m) { bf16_t* rowp = dst + (size_t)(row0 + ai * HALF + m * 16) * D_ + col0;
#pragma unroll
                for (int bj = 0; bj < 2; ++bj) { f32x4 v[2];
#pragma unroll
                    for (int n = 0; n < 2; ++n) { v[n] = acc[ai][bj][m][n] + bv[bj][n];
                        if (isy) {
#pragma unroll
                            for (int j = 0; j < 4; ++j) v[n][j] = gelu_tanh(v[n][j]); } }
                    const u32x2 lo = pack4(v[0]), hi = pack4(v[1]);
                    *(u32x4*)(rowp + bj * HALF) = (u32x4){lo.x, lo.y, hi.x, hi.y}; }
                __builtin_amdgcn_sched_barrier(0); }
    }
};
struct EpiGG {
    static constexpr int NDEF = 0;
    const bf16_t* XB; const float* ba; const float* bi; const float* lsl; bf16_t* Lout; bf16_t* Uout;
    __device__ __forceinline__ void operator()(const f32x4 (&acc)[2][2][4][2], const Unit& u, int wr, int wc, int fr, int fq) const {
        const unsigned ch0 = (unsigned)(u.pn * 128 + wc * 32 + 8 * fq);
        const unsigned o0 = (unsigned)(u.pm * BM + wr * 64 + fr) * (unsigned)D_ + ch0;
        u32x4 xw[2][4];
#pragma unroll
        for (int ai = 0; ai < 2; ++ai)
#pragma unroll
            for (int m = 0; m < 4; ++m) xw[ai][m] = *(const u32x4*)(XB + o0 + (unsigned)((ai * HALF + m * 16) * D_));
        f32x4 bav[2], biv[2], ls[2];
#pragma unroll
        for (int bj = 0; bj < 2; ++bj) { bav[bj] = *(const f32x4*)(ba + ch0 + 4 * bj); biv[bj] = *(const f32x4*)(bi + ch0 + 4 * bj); ls[bj] = *(const f32x4*)(lsl + ch0 + 4 * bj); }
        __builtin_amdgcn_sched_barrier(0);
#pragma unroll
        for (int ai = 0; ai < 2; ++ai)
#pragma unroll
            for (int m = 0; m < 4; ++m) { const unsigned o = o0 + (unsigned)((ai * HALF + m * 16) * D_);
                u32x2 lw[2], uw[2];
#pragma unroll
                for (int bj = 0; bj < 2; ++bj) {
                    const f32x4 xb = unpack4(bj ? (u32x2){xw[ai][m].z, xw[ai][m].w} : (u32x2){xw[ai][m].x, xw[ai][m].y});
                    const f32x4 pr = acc[ai][bj][m][0] + bav[bj], pi = acc[ai][bj][m][1] + biv[bj]; f32x4 av, uv;
#pragma unroll
                    for (int j = 0; j < 4; ++j) av[j] = sigmoidf_(pr[j]) * ls[bj][j];
                    lw[bj] = pack4(av); const f32x4 lr = unpack4(lw[bj]);
#pragma unroll
                    for (int j = 0; j < 4; ++j) { const float ig = sigmoidf_(pi[j]); const float a_ = __expf(lr[j]); uv[j] = __builtin_amdgcn_sqrtf(fmaxf(1.0f - a_ * a_, 0.f)) * ig * xb[j]; }
                    uw[bj] = pack4(uv); }
                *(u32x4*)(Lout + o) = (u32x4){lw[0].x, lw[0].y, lw[1].x, lw[1].y}; *(u32x4*)(Uout + o) = (u32x4){uw[0].x, uw[0].y, uw[1].x, uw[1].y};
                __builtin_amdgcn_sched_barrier(0); }
    }
};
}

__device__ void phase_wconv(const KArgs& a, LAS unsigned char* lds, int wv) {
    LAS float* tl = (LAS float*)lds;
    const int tid = opaque_tid(wv);
    unsigned char* ws = a.ws;
    const int bid = opaque_bid(), nblk = opaque_nblk();
    if (bid == nblk - 1) {
        float* lsl = (float*)(ws + OFF_LSL);
        for (int ch = tid; ch < 1024; ch += 512) { const float lam = a.in[14][ch]; const float x = __expf(-lam);
            const float l1p = x < 0.06f ? x * (1.0f - x * (0.5f - x * (0.33333334f - x * (0.25f - x * 0.2f)))) : __logf(1.0f + x);
            lsl[ch] = -8.0f * l1p; }
    }
    for (int tile = bid; tile < 2480; tile += nblk) {
        int t = tile, mode, K, ld; const float* s0; const float* s1 = nullptr; const float* gk = nullptr; bf16_t* dst;
        if (t < 1408)      { const int f = t / 352; t -= f * 352; mode = 1; K = 1024; ld = 2816; s0 = a.in[3] + (size_t)f * 1024 * 2816; s1 = a.in[4] + (size_t)f * 1024 * 2816; gk = a.in[1] + f * 2048; dst = (bf16_t*)(ws + OFF_WT1 + f * SZ_WT1); }
        else if (t < 2112) { t -= 1408; const int f = t / 176; t -= f * 176; mode = 0; K = 2816; ld = 1024; s0 = a.in[5] + (size_t)f * 2816 * 1024; dst = (bf16_t*)(ws + OFF_WT2 + f * SZ_WT2); }
        else if (t < 2240) { t -= 2112; mode = 0; K = 1024; ld = 2048; s0 = a.in[6]; gk = a.in[2]; dst = (bf16_t*)(ws + OFF_WIN); }
        else if (t < 2272) { t -= 2240; mode = 2; K = 256; ld = 256; s0 = a.in[10]; s1 = a.in[12]; dst = (bf16_t*)(ws + OFF_WGATE); }
        else if (t < 2336) { t -= 2272; mode = 0; K = 1024; ld = 1024; s0 = a.in[15]; dst = (bf16_t*)(ws + OFF_WOUT); }
        else if (t < 2416) { t -= 2336; mode = 0; K = 1024; ld = 1280; s0 = a.in[17]; gk = a.in[2] + 2048; dst = (bf16_t*)(ws + OFF_WQKV); }
        else               { t -= 2416; mode = 0; K = 1024; ld = 1024; s0 = a.in[20]; dst = (bf16_t*)(ws + OFF_WO); }
        const int nk = K >> 8, ct = t / nk, kt = t - ct * nk, k0 = kt * 256;
        const int cl = tid & 63, cw = tid >> 3;
        int rowl, roww;
        const float* cp;
        { const int slot = cl & 31, n = slot >> 4, fq = (slot >> 2) & 3, j = slot & 3;
          if (mode == 0) { rowl = ct * 64 + cl; cp = s0 + (rowl & ~31) + 8 * fq + 4 * n + j; }
          else { const int pn = ct >> 2, wc = ct & 3, bj = cl >> 5; rowl = 256 * pn + 128 * bj + 32 * wc + slot; const int hid = 128 * pn + 32 * wc + 8 * fq + 4 * bj + j;
              cp = (n ? s1 : s0) + (mode == 1 ? hid : (hid >> 8) * 65536 + (hid & 255)); } }
        if (mode == 0) roww = ct * 64 + cw; else roww = 256 * (ct >> 2) + 128 * (cw >> 5) + 32 * (ct & 3) + (cw & 31);
        (void)rowl;
        const int kl0 = tid >> 6;
        __syncthreads();
        if (gk) {
#pragma unroll
            for (int q = 0; q < 4; ++q)
#pragma unroll
                for (int i = 0; i < 8; ++i) { const int kl = kl0 + 8 * i, k = k0 + 64 * q + kl; tl[q * 4160 + cl * 65 + kl] = cp[(size_t)k * ld] * gk[k]; }
        } else {
#pragma unroll
            for (int q = 0; q < 4; ++q)
#pragma unroll
                for (int i = 0; i < 8; ++i) { const int kl = kl0 + 8 * i, k = k0 + 64 * q + kl; tl[q * 4160 + cl * 65 + kl] = cp[(size_t)k * ld]; }
        }
        __syncthreads();
        const int kc = tid & 7;
#pragma unroll
        for (int q = 0; q < 4; ++q) { const LAS float* tp = tl + q * 4160 + cw * 65 + 8 * kc;
            *(u32x4*)(dst + (size_t)roww * K + k0 + 64 * q + 8 * kc) = (u32x4){pk2(tp[0], tp[1]), pk2(tp[2], tp[3]), pk2(tp[4], tp[5]), pk2(tp[6], tp[7])}; }
    }
    __syncthreads();
}

__device__ void phase_row(const bf16_t* f, const float* gpost, float scale, const float* x, bf16_t* hb, float* rinv, float* out, int mode, int wv) {
    const int tid = opaque_tid(wv), lane = tid & 63, wid = tid >> 6;
    const int bid = opaque_bid(), nblk = opaque_nblk();
    f32x4 gp[4];
    if (mode != 0) {
#pragma unroll
        for (int i = 0; i < 4; ++i) gp[i] = *(const f32x4*)(gpost + 8 * lane + 512 * (i >> 1) + 4 * (i & 1));
    }
    const bool xl = (nblk == 256);
    const int rstart = xl ? 4096 * (bid & 7) + 128 * (bid >> 3) + 4 * wid : (bid * 8 + wid) * 4;
    const int rstep = xl ? 32 : nblk * 32, rend = xl ? 4096 * (bid & 7) + 128 * (bid >> 3) + 128 : T_;
    for (int row0 = rstart; row0 < rend; row0 += rstep) {
        f32x4 h[4][4]; u32x4 fw[4][2]; float ri[4];
        if (mode == 0) {
#pragma unroll
            for (int r = 0; r < 4; ++r)
#pragma unroll
                for (int i = 0; i < 4; ++i) h[r][i] = *(const f32x4*)(x + (size_t)(row0 + r) * D_ + 8 * lane + 512 * (i >> 1) + 4 * (i & 1));
        } else {
            u32x4 hw[4][2];
#pragma unroll
            for (int r = 0; r < 4; ++r) { ri[r] = rinv[row0 + r];
#pragma unroll
                for (int c = 0; c < 2; ++c) { hw[r][c] = *(const u32x4*)(hb + (size_t)(row0 + r) * D_ + 8 * lane + 512 * c); fw[r][c] = *(const u32x4*)(f + (size_t)(row0 + r) * D_ + 8 * lane + 512 * c); } }
#pragma unroll
            for (int r = 0; r < 4; ++r) {
                float ss = 0.f; f32x4 fv[4];
#pragma unroll
                for (int c = 0; c < 2; ++c) { fv[2 * c] = unpack4((u32x2){fw[r][c].x, fw[r][c].y}); fv[2 * c + 1] = unpack4((u32x2){fw[r][c].z, fw[r][c].w});
                    h[r][2 * c] = unpack4((u32x2){hw[r][c].x, hw[r][c].y}) * ri[r]; h[r][2 * c + 1] = unpack4((u32x2){hw[r][c].z, hw[r][c].w}) * ri[r]; }
#pragma unroll
                for (int i = 0; i < 4; ++i) ss += fv[i][0] * fv[i][0] + fv[i][1] * fv[i][1] + fv[i][2] * fv[i][2] + fv[i][3] * fv[i][3];
                ss = wave_sum(ss, lane);
                const float rs = rsqrtf(ss * (1.0f / 1024.0f) + 1e-6f) * scale;
#pragma unroll
                for (int i = 0; i < 4; ++i) h[r][i] += fv[i] * rs * gp[i];
            }
        }
        if (mode == 2) {
#pragma unroll
            for (int r = 0; r < 4; ++r)
#pragma unroll
                for (int i = 0; i < 4; ++i) *(f32x4*)(out + (size_t)(row0 + r) * D_ + 8 * lane + 512 * (i >> 1) + 4 * (i & 1)) = h[r][i];
        } else {
#pragma unroll
            for (int r = 0; r < 4; ++r) {
                float ss = 0.f;
#pragma unroll
                for (int i = 0; i < 4; ++i) ss += h[r][i][0] * h[r][i][0] + h[r][i][1] * h[r][i][1] + h[r][i][2] * h[r][i][2] + h[r][i][3] * h[r][i][3];
                ss = wave_sum(ss, lane);
                const float ms = ss * (1.0f / 1024.0f) + 1e-6f, rs = rsqrtf(ms);
#pragma unroll
                for (int c = 0; c < 2; ++c) { const u32x2 lo = pack4(h[r][2 * c] * rs), hi = pack4(h[r][2 * c + 1] * rs);
                    *(u32x4*)(hb + (size_t)(row0 + r) * D_ + 8 * lane + 512 * c) = (u32x4){lo.x, lo.y, hi.x, hi.y}; }
                if (lane == 0) rinv[row0 + r] = ms * rs;
            }
        }
    }
}

__device__ void phase_conv(const bf16_t* xpre, const float* cw, const float* cb, bf16_t* xb, int wv) {
    const int nblk_ = opaque_nblk();
    const int gt = xcd_major_bid(opaque_bid(), nblk_) * 512 + opaque_tid(wv), nt = nblk_ * 512;
    if (nt != 131072) {
        for (int idx = gt; idx < T_ * 128; idx += nt) {
            const int t = idx >> 7, ch = (idx & 127) * 8, s = t & (S_ - 1);
            f32x4 a0 = *(const f32x4*)(cb + ch), a1 = *(const f32x4*)(cb + ch + 4);
            u32x4 w[4];
#pragma unroll
            for (int k = 0; k < 4; ++k) { const int ds = 3 - k; w[k] = *(const u32x4*)(xpre + (size_t)(s >= ds ? t - ds : t) * D_ + ch); }
#pragma unroll
            for (int k = 0; k < 4; ++k) { const int ds = 3 - k; const float m = s >= ds ? 1.0f : 0.0f;
                const f32x4 w0 = *(const f32x4*)(cw + k * D_ + ch) * m, w1 = *(const f32x4*)(cw + k * D_ + ch + 4) * m;
                a0 += w0 * (f32x4){bflo(w[k].x), bfhi(w[k].x), bflo(w[k].y), bfhi(w[k].y)}; a1 += w1 * (f32x4){bflo(w[k].z), bfhi(w[k].z), bflo(w[k].w), bfhi(w[k].w)}; }
            *(u32x4*)(xb + (size_t)t * D_ + ch) = (u32x4){pk2(a0[0], a0[1]), pk2(a0[2], a0[3]), pk2(a1[0], a1[1]), pk2(a1[2], a1[3])};
        }
        return;
    }
    const int ch = (gt & 127) * 8, tb = (gt >> 7) * 32;
    f32x4 wk0[4], wk1[4];
#pragma unroll
    for (int k = 0; k < 4; ++k) { wk0[k] = *(const f32x4*)(cw + k * D_ + ch); wk1[k] = *(const f32x4*)(cw + k * D_ + ch + 4); }
    const f32x4 b0 = *(const f32x4*)(cb + ch), b1 = *(const f32x4*)(cb + ch + 4);
#pragma unroll 1
    for (int it = 0; it < 32; it += 4) {
        u32x4 w[4][4];
#pragma unroll
        for (int q = 0; q < 4; ++q) { const int t = tb + (it + q), s = t & (S_ - 1);
#pragma unroll
            for (int k = 0; k < 4; ++k) { const int ds = 3 - k; w[q][k] = *(const u32x4*)(xpre + (size_t)(s >= ds ? t - ds : t) * D_ + ch); } }
#pragma unroll
        for (int q = 0; q < 4; ++q) { const int t = tb + (it + q), s = t & (S_ - 1);
            f32x4 a0 = b0, a1 = b1;
#pragma unroll
            for (int k = 0; k < 4; ++k) { const int ds = 3 - k; const float m = s >= ds ? 1.0f : 0.0f;
                a0 += (wk0[k] * m) * (f32x4){bflo(w[q][k].x), bfhi(w[q][k].x), bflo(w[q][k].y), bfhi(w[q][k].y)}; a1 += (wk1[k] * m) * (f32x4){bflo(w[q][k].z), bfhi(w[q][k].z), bflo(w[q][k].w), bfhi(w[q][k].w)}; }
            *(u32x4*)(xb + (size_t)t * D_ + ch) = (u32x4){pk2(a0[0], a0[1]), pk2(a0[2], a0[3]), pk2(a1[0], a1[1]), pk2(a1[2], a1[3])}; }
    }
}

__device__ __forceinline__ f32x4 exp4(f32x4 v) { return (f32x4){__expf(v[0]), __expf(v[1]), __expf(v[2]), __expf(v[3])}; }
__device__ void phase_scan1(const bf16_t* A, const bf16_t* U, float* P, float* H, int wv) {
    const int nblk_ = opaque_nblk();
    const int gt = xcd_major_bid(opaque_bid(), nblk_) * 512 + opaque_tid(wv), nt = nblk_ * 512;
    for (int it = gt; it < 131072; it += nt) {
        const int c4 = it & 255, bc = it >> 8;
        const size_t base = (size_t)bc * 64 * D_ + c4 * 4;
        f32x4 h = {0.f, 0.f, 0.f, 0.f}, p = {0.f, 0.f, 0.f, 0.f};
#pragma unroll 8
        for (int s = 0; s < 64; ++s) { const f32x4 lv = unpack4(*(const u32x2*)(A + base + (size_t)s * D_)); const f32x4 uv = unpack4(*(const u32x2*)(U + base + (size_t)s * D_)); h = exp4(lv) * h + uv; p += lv; }
        *(f32x4*)(P + (size_t)bc * D_ + c4 * 4) = exp4(p); *(f32x4*)(H + (size_t)bc * D_ + c4 * 4) = h;
    }
}
__device__ void phase_scan2(const bf16_t* A, const bf16_t* U, const float* P, const float* H, bf16_t* Y, int wv) {
    const int nblk_ = opaque_nblk();
    const int gt = xcd_major_bid(opaque_bid(), nblk_) * 512 + opaque_tid(wv), nt = nblk_ * 512;
    for (int it = gt; it < 131072; it += nt) {
        const int c4 = it & 255, bc = it >> 8, c = bc & 63, b0 = bc - c;
        f32x4 h = {0.f, 0.f, 0.f, 0.f};
#pragma unroll 4
        for (int cc = 0; cc < c; ++cc) { const size_t o = (size_t)(b0 + cc) * D_ + c4 * 4; const f32x4 pp = *(const f32x4*)(P + o), hh = *(const f32x4*)(H + o); h = pp * h + hh; }
        const size_t base = (size_t)bc * 64 * D_ + c4 * 4;
#pragma unroll 8
        for (int s = 0; s < 64; ++s) { const size_t o = base + (size_t)s * D_;
            const f32x4 lv = unpack4(*(const u32x2*)(A + o)); const f32x4 uv = unpack4(*(const u32x2*)(U + o)); const f32x4 yv = unpack4(*(const u32x2*)(Y + o));
            h = exp4(lv) * h + uv; *(u32x2*)(Y + o) = pack4(h * yv); }
    }
}

__device__ void phase_attn(LAS unsigned char* lds, const bf16_t* qkv, const float* sinks, bf16_t* out, int wv) {
    const int tid = opaque_tid(wv), lane = tid & 63, wid = __builtin_amdgcn_readfirstlane(tid >> 6), fr = lane & 15, g = lane >> 4;
    LAS unsigned char* Ks = lds;
    LAS unsigned char* Vt = lds + 36864;
    const int nblk = opaque_nblk(), bid = xcd_major_bid(opaque_bid(), nblk);
    unsigned zz = 0u; asm volatile("" : "+v"(zz));
    const u32x4 zero4 = {zz, zz, zz, zz};
    const int ipb = (512 + nblk - 1) / nblk;
    for (int item = bid * ipb; item < 512 && item < (bid + 1) * ipb; ++item) {
        const int kvh = item & 1, nb = (item >> 1) & 31, b = item >> 6;
        const int tok0 = b * S_ + nb * 128;
        __syncthreads();
        if (tid < 192) { const int row = tid / 3, part = tid - row * 3; *(LAS u32x4*)(Vt + row * 560 + 512 + part * 16) = zero4; }
#pragma unroll
        for (int i = 0; i < 4; ++i) { const int e = tid + 512 * i, kj = e >> 3, part = e & 7;
            const bool live = (nb > 0 || kj >= 128);
            const bf16_t* p = qkv + (size_t)(live ? tok0 - 128 + kj : tok0) * 1280 + 1024 + kvh * 64 + part * 8;
            u32x4 kv = *(const u32x4*)p, vv = *(const u32x4*)(p + 128);
            if (!live) { kv = zero4; vv = zero4; }
            *(LAS u32x4*)(Ks + kj * 144 + part * 16) = kv;
            LAS unsigned short* vt = (LAS unsigned short*)(Vt + (part * 8) * 560 + kj * 2);
            vt[0 * 280] = (unsigned short)(vv.x & 0xffffu); vt[1 * 280] = (unsigned short)(vv.x >> 16);
            vt[2 * 280] = (unsigned short)(vv.y & 0xffffu); vt[3 * 280] = (unsigned short)(vv.y >> 16);
            vt[4 * 280] = (unsigned short)(vv.z & 0xffffu); vt[5 * 280] = (unsigned short)(vv.z >> 16);
            vt[6 * 280] = (unsigned short)(vv.w & 0xffffu); vt[7 * 280] = (unsigned short)(vv.w >> 16); }
        __syncthreads();
        const int qi = 16 * wid + fr;
        const size_t tok = (size_t)(tok0 + qi);
        const bf16_t* qp = qkv + tok * 1280 + kvh * 512 + 8 * g;
        bf16x8 q0n = *(const bf16x8*)qp, q1n = *(const bf16x8*)(qp + 32);
#pragma unroll 4
        for (int hh = 0; hh < 8; ++hh) {
            const int h = kvh * 8 + hh;
            const bf16x8 q0 = q0n, q1 = q1n;
            if (hh < 7) { q0n = *(const bf16x8*)(qp + (hh + 1) * 64); q1n = *(const bf16x8*)(qp + (hh + 1) * 64 + 32); }
            f32x4 sc[10];
#pragma unroll
            for (int i = 0; i < 10; ++i) { sc[i] = (f32x4){0.f, 0.f, 0.f, 0.f};
                if (i < 9 && wid + i < 16) { const LAS unsigned char* kp = Ks + (16 * (wid + i) + fr) * 144 + g * 16;
                    const bf16x8 k0 = *(const LAS bf16x8*)kp, k1 = *(const LAS bf16x8*)(kp + 64);
                    sc[i] = __builtin_amdgcn_mfma_f32_16x16x32_bf16(k0, q0, sc[i], 0, 0, 0);
                    sc[i] = __builtin_amdgcn_mfma_f32_16x16x32_bf16(k1, q1, sc[i], 0, 0, 0); } }
            float mx = -1e30f;
#pragma unroll
            for (int i = 0; i < 10; ++i) {
                const bool tile_ok = (i < 9) && (wid + i < 16) && (nb > 0 || wid + i >= 8);
#pragma unroll
                for (int r = 0; r < 4; ++r) { bool valid = tile_ok;
                    if (i == 0 || i == 8) { const int kj = 16 * (wid + i) + 4 * g + r, d = qi + 128 - kj; valid = valid && (d >= 0) && (d < 128); }
                    const float s = valid ? sc[i][r] * 0.125f : -1e30f; sc[i][r] = s; mx = fmaxf(mx, s); } }
            mx = fmaxf(mx, shfl_xor_f(mx, 16, lane)); mx = fmaxf(mx, shfl_xor_f(mx, 32, lane));
            const float sk = sinks[h]; mx = fmaxf(mx, sk);
            float sum = 0.f;
#pragma unroll
            for (int i = 0; i < 10; ++i)
#pragma unroll
                for (int r = 0; r < 4; ++r) { const float p = (sc[i][r] > -1e29f) ? __expf(sc[i][r] - mx) : 0.f; sc[i][r] = p; sum += p; }
            sum += shfl_xor_f(sum, 16, lane); sum += shfl_xor_f(sum, 32, lane);
            sum += __expf(sk - mx);
            const float inv = __builtin_amdgcn_rcpf(sum);
            f32x4 o[4];
#pragma unroll
            for (int dt = 0; dt < 4; ++dt) o[dt] = (f32x4){0.f, 0.f, 0.f, 0.f};
#pragma unroll
            for (int s2 = 0; s2 < 5; ++s2) {
                const u32x4 pw = {pk2(sc[2 * s2][0], sc[2 * s2][1]), pk2(sc[2 * s2][2], sc[2 * s2][3]), pk2(sc[2 * s2 + 1][0], sc[2 * s2 + 1][1]), pk2(sc[2 * s2 + 1][2], sc[2 * s2 + 1][3])};
                const bf16x8 pf = __builtin_bit_cast(bf16x8, pw);
#pragma unroll
                for (int dt = 0; dt < 4; ++dt) { const LAS unsigned char* vp = Vt + (16 * dt + fr) * 560 + (16 * (wid + 2 * s2) + 4 * g) * 2;
                    const u32x2 lo = *(const LAS u32x2*)vp, hi = *(const LAS u32x2*)(vp + 32);
                    const bf16x8 vf = __builtin_bit_cast(bf16x8, ((u32x4){lo.x, lo.y, hi.x, hi.y}));
                    o[dt] = __builtin_amdgcn_mfma_f32_16x16x32_bf16(vf, pf, o[dt], 0, 0, 0); } }
            bf16_t* op = out + tok * D_ + h * 64 + 4 * g;
#pragma unroll
            for (int dt = 0; dt < 4; ++dt) *(u32x2*)(op + 16 * dt) = pack4(o[dt] * inv);
        }
    }
    __syncthreads();
}


#define XB_TMO      128
#define XB_XCNT(j)  (256  + 64 * (j))
#define XB_XSUB(j)  (1280 + 64 * (j))
#define XB_XGEN(j)  (2304 + 64 * (j))
#define XB_TOP      3328
#define XB_TOPGEN   3392
#define XCD_BAR_WORDS 3456
#define XB_SPIN_CAP (1u << 20)
__device__ __forceinline__ unsigned xb_ld(unsigned* p)              { return __hip_atomic_load(p, __ATOMIC_RELAXED, __HIP_MEMORY_SCOPE_AGENT); }
__device__ __forceinline__ unsigned xb_add(unsigned* p, unsigned v) { return __hip_atomic_fetch_add(p, v, __ATOMIC_RELAXED, __HIP_MEMORY_SCOPE_AGENT); }
__device__ __forceinline__ unsigned xb_xcc_id() { return (unsigned)__builtin_amdgcn_s_getreg((3 << 11) | 20) & 0xFu; }
#define XB_SPIN(cond, bar) do { unsigned _sp = 0; while (cond) { __builtin_amdgcn_s_sleep(1); \
    if ((++_sp & 255u) == 0u) { if (xb_ld(&(bar)[XB_TMO])) break; if (_sp > XB_SPIN_CAP) { atomicAdd(&(bar)[XB_TMO], 1u); break; } } } } while (0)
__device__ __forceinline__ void xcd_barrier_complete(unsigned* bar, unsigned x, unsigned G, unsigned& nloc, unsigned& nx) {
    unsigned sum, cnt, mine, sp = 0u;
    for (;;) {
        sum = 0u; cnt = 0u; mine = 0u;
#pragma unroll
        for (unsigned j = 0; j < 16; ++j) { const unsigned c = xb_ld(&bar[XB_XCNT(j)]); sum += c; cnt += (c > 0u) ? 1u : 0u; mine = (j == x) ? c : mine; }
        if (sum == G) break;
        __builtin_amdgcn_s_sleep(1);
        if ((++sp & 255u) == 0u) { if (xb_ld(&bar[XB_TMO])) break; if (sp > XB_SPIN_CAP) { atomicAdd(&bar[XB_TMO], 1u); break; } }
    }
    nloc = mine > 0u ? mine : 1u; nx = cnt > 0u ? cnt : 1u;
}
__device__ __forceinline__ bool is_thread0(int wv) { return wv == 0 && opaque_lane() == 0; }
__device__ __forceinline__ void xcd_barrier(unsigned* bar, volatile LAS unsigned* st, int wv) {
    asm volatile("s_waitcnt vmcnt(0)" ::: "memory");
    __syncthreads();
    if (is_thread0(wv)) {
        __builtin_amdgcn_s_waitcnt(0);
        const unsigned x = xb_xcc_id();
        unsigned nloc = st[0], nx = st[1];
        if (nloc == 0u) { xcd_barrier_complete(bar, x, gridDim.x, nloc, nx); st[0] = nloc; st[1] = nx; }
        const unsigned old = xb_add(&bar[XB_XSUB(x)], 1u);
        const unsigned gen = old / nloc;
        if (old + 1u == (gen + 1u) * nloc) {
            __builtin_amdgcn_fence(__ATOMIC_RELEASE, "agent");
            asm volatile("s_waitcnt vmcnt(0)" ::: "memory");
            const unsigned og = xb_add(&bar[XB_TOP], 1u);
            const unsigned tg = og / nx;
            if (og + 1u == (tg + 1u) * nx) xb_add(&bar[XB_TOPGEN], 1u);
            else XB_SPIN(xb_ld(&bar[XB_TOPGEN]) == tg, bar);
            __builtin_amdgcn_fence(__ATOMIC_ACQUIRE, "agent");
            xb_add(&bar[XB_XGEN(x)], 1u);
            asm volatile("s_waitcnt vmcnt(0)" ::: "memory");
        } else {
            XB_SPIN(xb_ld(&bar[XB_XGEN(x)]) == gen, bar);
            __builtin_amdgcn_fence(__ATOMIC_ACQUIRE, "agent");
            asm volatile("s_waitcnt vmcnt(0)" ::: "memory");
        }
    }
    __syncthreads();
}

__device__ __forceinline__ void run_phase(const KArgs& a, int ph, LAS unsigned char* lds, int wv) {
    unsigned char* ws = a.ws;
    bf16_t* ABUF = (bf16_t*)(ws + OFF_ABUF); bf16_t* FBUF = (bf16_t*)(ws + OFF_FBUF); bf16_t* HBUF = (bf16_t*)(ws + OFF_HBUF);
    float* EBUF = (float*)(ws + OFF_EBUF);
    bf16_t* YBUF = HBUF;
    bf16_t* XPRE = HBUF + (size_t)T_ * D_;
    float* PBUF = (float*)(HBUF + (size_t)2 * T_ * D_);
    float* HEND = PBUF + 512 * 1024;
    bf16_t* XB = (bf16_t*)a.out;
    float* ROWSQ = (float*)(ws + OFF_RSQ);
    bf16_t* UBUF = FBUF;
    bf16_t* QKV = HBUF;
    bf16_t* AOUT = HBUF + (size_t)T_ * 1280;
    const float* lsl = (const float*)(ws + OFF_LSL);
    pg8::StaticOrder S;
    switch (ph) {
    case 0:
        phase_wconv(a, lds, wv);
        phase_row(nullptr, nullptr, 0.f, a.in[0], ABUF, ROWSQ, nullptr, 0, wv);
        break;
    case 1: case 11: case 14: case 21: {
        const int fi = ph == 1 ? 0 : ph == 11 ? 1 : ph == 14 ? 2 : 3;
        pg8::Gemm g{ABUF, (const bf16_t*)(ws + OFF_WT1 + fi * SZ_WT1), T_, 5632, 1024, 1024, 0};
        S.init(g.M, g.N, opaque_nblk(), opaque_bid());
        pg8::EpiG1 E{HBUF};
        pg8::gemm_phase(lds, g, S, E, wv);
    } break;
    case 2: case 12: case 15: case 22: case 9: case 19: case 17: {
        pg8::Gemm g; pg8::EpiStore E;
        if (ph == 9)       { g = pg8::Gemm{YBUF, (const bf16_t*)(ws + OFF_WOUT), T_, 1024, 1024, 1024, 0}; E = pg8::EpiStore{FBUF, 1024, a.in[16]}; }
        else if (ph == 19) { g = pg8::Gemm{AOUT, (const bf16_t*)(ws + OFF_WO), T_, 1024, 1024, 1024, 0}; E = pg8::EpiStore{FBUF, 1024, a.in[21]}; }
        else if (ph == 17) { g = pg8::Gemm{ABUF, (const bf16_t*)(ws + OFF_WQKV), T_, 1280, 1024, 1024, 0}; E = pg8::EpiStore{QKV, 1280, a.in[18]}; }
        else { const int fi = ph == 2 ? 0 : ph == 12 ? 1 : ph == 15 ? 2 : 3;
            g = pg8::Gemm{HBUF, (const bf16_t*)(ws + OFF_WT2 + fi * SZ_WT2), T_, 1024, 2816, 2816, 0}; E = pg8::EpiStore{FBUF, 1024, nullptr}; }
        S.init(g.M, g.N, opaque_nblk(), opaque_bid());
        pg8::gemm_phase(lds, g, S, E, wv);
    } break;
    case 3: case 10: case 13: case 16: case 20: case 23: {
        const float* nf = a.in[1]; const float* nm = a.in[2];
        const float* gpost; float scale = 0.5f;
        if (ph == 3)       { gpost = nf + 1 * 1024; }
        else if (ph == 10) { gpost = nm + 1 * 1024; scale = 1.0f; }
        else if (ph == 13) { gpost = nf + 3 * 1024; }
        else if (ph == 16) { gpost = nf + 5 * 1024; }
        else if (ph == 20) { gpost = nm + 3 * 1024; scale = 1.0f; }
        else               { gpost = nf + 7 * 1024; }
        phase_row(FBUF, gpost, scale, nullptr, ABUF, ROWSQ, a.out, ph == 23 ? 2 : 1, wv);
    } break;
    case 4: {
        pg8::Gemm g{ABUF, (const bf16_t*)(ws + OFF_WIN), T_, 2048, 1024, 1024, 0};
        S.init(g.M, g.N, opaque_nblk(), opaque_bid());
        pg8::EpiGP E{YBUF, XPRE, a.in[7]};
        pg8::gemm_phase(lds, g, S, E, wv);
    } break;
    case 5: phase_conv(XPRE, a.in[8], a.in[9], XB, wv); break;
    case 6: {
        pg8::Gemm g{XB, (const bf16_t*)(ws + OFF_WGATE), T_, 2048, 256, 1024, 256};
        S.init(g.M, g.N, opaque_nblk(), opaque_bid());
        pg8::EpiGG E{XB, a.in[11], a.in[13], lsl, (bf16_t*)EBUF, UBUF};
        pg8::gemm_phase(lds, g, S, E, wv);
    } break;
    case 7: phase_scan1((const bf16_t*)EBUF, UBUF, PBUF, HEND, wv); break;
    case 8: phase_scan2((const bf16_t*)EBUF, UBUF, PBUF, HEND, YBUF, wv); break;
    case 18: phase_attn(lds, QKV, a.in[19], AOUT, wv); break;
    default: break;
    }
}

__global__ void __launch_bounds__(512, 2) mega_fwd(Args a_unused) {
    extern __shared__ __attribute__((aligned(16))) unsigned char shm[];
    LAS unsigned char* lds = (LAS unsigned char*)shm;
    cg::grid_group grid = cg::this_grid();
    const int wv = __builtin_amdgcn_readfirstlane((int)threadIdx.x >> 6);
    KArgs* ap = (KArgs*)__builtin_amdgcn_kernarg_segment_ptr();
    const int ph_lo = ap->ph_lo, ph_hi = ap->ph_hi;
    volatile LAS unsigned* st = (volatile LAS unsigned*)(lds + LDS_GEMM);
    if (threadIdx.x == 0) { st[0] = 0u; st[1] = 0u; }
    __syncthreads();
#if PROBE_MASK || PROBE_CONST
    unsigned long long* stamps = (unsigned long long*)(ap->ws + 24576);
    const unsigned long long t_entry = __builtin_amdgcn_s_memrealtime();
    if (blockIdx.x == 0 && is_thread0(wv)) { stamps[0] = t_entry; __hip_atomic_store(stamps + 40, ~0ull, __ATOMIC_RELAXED, __HIP_MEMORY_SCOPE_AGENT); __hip_atomic_store(stamps + 41, 0ull, __ATOMIC_RELAXED, __HIP_MEMORY_SCOPE_AGENT); }
#endif
#if PROBE_MASK || PROBE_CONST
#define MK_STAMP(k) do { if (blockIdx.x == 0 && is_thread0(wv)) stamps[(k) + 1] = __builtin_amdgcn_s_memrealtime(); } while (0)
#else
#define MK_STAMP(k) do { } while (0)
#endif
#define MK_PHASE(k) do { if ((k) >= ph_lo && (k) < ph_hi) { KArgs* ap2 = ap; asm volatile("" : "+s"(ap2)); run_phase(*ap2, (k), lds, wv); \
        if ((k) + 1 < ph_hi) xcd_barrier((unsigned*)ap2->ws, st, wv); \
        MK_STAMP(k); } } while (0)
    if (ph_lo < 0) grid.sync();
    if (is_thread0(wv)) (void)xb_add((unsigned*)ap->ws + XB_XCNT(xb_xcc_id()), 1u);
    MK_PHASE(0);  MK_PHASE(1);  MK_PHASE(2);  MK_PHASE(3);  MK_PHASE(4);  MK_PHASE(5);  MK_PHASE(6);  MK_PHASE(7);
    MK_PHASE(8);  MK_PHASE(9);  MK_PHASE(10); MK_PHASE(11); MK_PHASE(12); MK_PHASE(13); MK_PHASE(14); MK_PHASE(15);
    MK_PHASE(16); MK_PHASE(17); MK_PHASE(18); MK_PHASE(19); MK_PHASE(20); MK_PHASE(21); MK_PHASE(22); MK_PHASE(23);
#undef MK_PHASE
#undef MK_STAMP
#if PROBE_MASK || PROBE_CONST
    if (PROBE_MASK & 0x1000000u) {
        if (is_thread0(wv)) { atomicMin(stamps + 40, t_entry); atomicMax(stamps + 41, (unsigned long long)__builtin_amdgcn_s_memrealtime()); }
        xcd_barrier((unsigned*)ap->ws, st, wv);
    }
    if (blockIdx.x == 0) {
        asm volatile("s_waitcnt vmcnt(0)" ::: "memory");
        __syncthreads();
        unsigned long long ticks = 0;
        for (int ph = 0; ph < NPHASE; ++ph) if ((PROBE_MASK >> ph) & 1u) ticks += stamps[ph + 1] - stamps[ph];
        if (PROBE_MASK & 0x1000000u) ticks = __hip_atomic_load(stamps + 41, __ATOMIC_RELAXED, __HIP_MEMORY_SCOPE_AGENT) - __hip_atomic_load(stamps + 40, __ATOMIC_RELAXED, __HIP_MEMORY_SCOPE_AGENT);
        int m = PROBE_CONST ? PROBE_CONST : (int)(ticks / 10ull);
        if (m > 32768) m = 32768;
        for (int i = opaque_tid(wv); i < m; i += 512) atomicAdd(ap->out + i, 0.05f);
    }
#endif
}

extern "C" void kernel_launch(void* const* d_in, const int* in_sizes, int n_in, void* d_out, int out_size, void* d_ws, size_t ws_size, hipStream_t stream) {
    static int grid = 0;
    if (grid == 0) {
        if (n_in != 22 || out_size != T_ * D_ || ws_size < WS_END) { fprintf(stderr, "kernel_launch: unexpected shapes (n_in %d out %d ws %zu need %zu)\n", n_in, out_size, ws_size, (size_t)WS_END); grid = -1; return; }
        int dev = 0, cus = 0, per_cu = 0;
        hipGetDevice(&dev);
        hipDeviceGetAttribute(&cus, hipDeviceAttributeMultiprocessorCount, dev);
        if (hipFuncSetAttribute((const void*)mega_fwd, hipFuncAttributeMaxDynamicSharedMemorySize, LDS_BYTES) != hipSuccess) { fprintf(stderr, "kernel_launch: hipFuncSetAttribute failed\n"); grid = -1; return; }
        hipOccupancyMaxActiveBlocksPerMultiprocessor(&per_cu, (const void*)mega_fwd, 512, LDS_BYTES);
        if (per_cu < 1) { fprintf(stderr, "kernel_launch: occupancy query says %d blocks per CU\n", per_cu); grid = -1; return; }
        grid = cus;
    }
    if (grid < 0) return;
    if (hipMemsetAsync(d_ws, 0, 16384, stream) != hipSuccess) { fprintf(stderr, "kernel_launch: memset of the barrier words failed\n"); return; }
    Args a{};
    for (int i = 0; i < 22; ++i) a.in[i] = (const float*)d_in[i];
    a.out = (float*)d_out; a.ws = (unsigned char*)d_ws;
#if N_LAUNCH_PER_PHASE
    for (int ph = 0; ph < NPHASE; ++ph) {
        a.ph_lo = ph; a.ph_hi = ph + 1;
        void* args[] = {&a};
        hipError_t e = hipLaunchCooperativeKernel((const void*)mega_fwd, dim3(grid), dim3(512), args, LDS_BYTES, stream);
        if (e != hipSuccess) { fprintf(stderr, "cooperative launch failed: %s\n", hipGetErrorString(e)); break; }
    }
#else
    a.ph_lo = 0; a.ph_hi = NPHASE;
    void* args[] = {&a};
    hipError_t e = hipLaunchCooperativeKernel((const void*)mega_fwd, dim3(grid), dim3(512), args, LDS_BYTES, stream);
    if (e != hipSuccess) fprintf(stderr, "cooperative launch failed: %s (grid %d)\n", hipGetErrorString(e), grid);
#endif
}
```
